# Optimizing an MI355X kernel written in HIP

```python
import math
import jax, jax.numpy as jnp
from jax import lax
import numpy as np

D_MODEL = 2048
BATCH = 2
SEQ = 4096
DEPTH = 4
DEC_BATCH = 8
DEC_SEQ = 8
PAST_LEN = 16384
PAGE_SIZE = 128

D_MIX = D_MODEL
HEAD_DIM_A = 64
D_A = (3 * D_MIX) // 8
H_A = D_A // HEAD_DIM_A
D_B = D_MIX // 4
G_B = 4
C_B = D_B // G_B
CHUNK_B = 128
D_C = D_MIX - D_A - D_B
DH_C = 128
H_C = D_C // DH_C
CHUNK_C = 128
CONV_W = 4
PATTERNS = ((128, 1), (512, 4), (2048, 16))
WIN_MAX = 2048
BLK_A = 128
N_BUCKETS = 32
MAX_DIST = 2048
EPS = 1e-6

_SIZES = (D_A, D_A, D_A, D_A, D_B, D_B, D_B, 2 * D_C, D_C, D_C, D_C, H_C, H_C)
D_IN = sum(_SIZES)
SPLIT_IDX = tuple(int(s) for s in np.cumsum(_SIZES)[:-1])

kernel_name = 'hybrid_dilated_gmlp_mlstm_decoder_step'


def _rmsnorm(x, g):
    xf = x.astype(jnp.float32)
    y = xf * lax.rsqrt(jnp.mean(xf * xf, axis=-1, keepdims=True) + EPS)
    return (y * g.astype(jnp.float32)).astype(x.dtype)


def _t5_bucket(dist):
    max_exact = N_BUCKETS // 2
    df = jnp.maximum(dist, 1).astype(jnp.float32)
    large = max_exact + (jnp.log(df / max_exact) / math.log(MAX_DIST / max_exact)
                         * (N_BUCKETS - max_exact)).astype(jnp.int32)
    return jnp.where(dist < max_exact, dist, jnp.minimum(large, N_BUCKETS - 1))


def _combine(outs, lses):
    w = jax.nn.softmax(jnp.stack(lses), axis=0)
    return jnp.einsum('pbsh,pbshd->bshd', w, jnp.stack(outs))


def _dilated_attn_prompt(q, k, v, rel_bias):
    B, S, H, Dh = q.shape
    outs, lses = [], []
    for win, dil in PATTERNS:
        n_back = win // dil
        blk = BLK_A
        nb = -(-S // (dil * blk))
        sp = nb * blk * dil
        padw = ((0, 0), (0, sp - S), (0, 0), (0, 0))
        qs = jnp.pad(q, padw).reshape(B, nb, blk, dil, H, Dh)
        ks = jnp.pad(k, padw).reshape(B, nb, blk, dil, H, Dh)
        vs = jnp.pad(v, padw).reshape(B, nb, blk, dil, H, Dh)
        prev = ((0, 0), (1, 0), (0, 0), (0, 0), (0, 0), (0, 0))
        kk = jnp.concatenate([jnp.pad(ks, prev)[:, :-1], ks], axis=2)
        vv = jnp.concatenate([jnp.pad(vs, prev)[:, :-1], vs], axis=2)
        qi = jnp.arange(blk)[:, None]
        ki = jnp.arange(2 * blk)[None, :]
        j = qi + blk - ki
        band = (j >= 0) & (j <= n_back)
        first = (jnp.arange(nb) == 0)[:, None, None] & (ki < blk)[None]
        mask = band[None] & ~first
        bias = rel_bias[_t5_bucket(jnp.clip(j, 0, n_back) * dil)].astype(jnp.float32).transpose(2, 0, 1)
        s = jnp.einsum('bnqrhd,bnkrhd->bnrhqk', qs, kk).astype(jnp.float32) + bias
        s = jnp.where(mask[None, :, None, None], s, -jnp.inf)
        lse = jax.nn.logsumexp(s, axis=-1)
        p = jnp.exp(s - lse[..., None])
        o = jnp.einsum('bnrhqk,bnkrhd->bnqrhd', p, vv.astype(jnp.float32))
        outs.append(o.reshape(B, sp, H, Dh)[:, :S])
        lses.append(lse.transpose(0, 1, 4, 2, 3).reshape(B, sp, H)[:, :S])
    return _combine(outs, lses)


def _dilated_attn_sample(q, k_all, v_all, rel_bias, n_past):
    T = q.shape[1]
    outs, lses = [], []
    for win, dil in PATTERNS:
        jj = jnp.arange(win // dil + 1)
        idx = n_past + jnp.arange(T)[:, None] - jj[None, :] * dil
        valid = idx >= 0
        idx = jnp.maximum(idx, 0)
        kg = k_all[:, idx]
        vg = v_all[:, idx]
        bias = rel_bias[_t5_bucket(jj * dil)].astype(jnp.float32).T
        s = jnp.einsum('bthd,btjhd->bthj', q, kg).astype(jnp.float32) + bias[None, None]
        s = jnp.where(valid[None, :, None, :], s, -jnp.inf)
        lse = jax.nn.logsumexp(s, axis=-1)
        p = jnp.exp(s - lse[..., None])
        outs.append(jnp.einsum('bthj,btjhd->bthd', p, vg.astype(jnp.float32)))
        lses.append(lse)
    return _combine(outs, lses)


def _sgu(u, vn, w_s, b_s):
    B, S, _ = u.shape
    L = min(CHUNK_B, S)
    nc = S // L
    w = jnp.tril(w_s[:, :L, :L])
    vg = vn.reshape(B, nc, L, G_B, C_B)
    mix = jnp.einsum('gts,bnsgc->bntgc', w, vg) + b_s[:, :L].T[None, None, :, :, None]
    return u * mix.reshape(B, S, D_B).astype(u.dtype)


def _mlstm(q, k, v, i_pre, f_pre, C0, n0, m0):
    B, S, H, D = q.shape
    L = min(CHUNK_C, S)
    nc = S // L
    f32 = jnp.float32
    q = q.astype(f32)
    k = k.astype(f32) * (D ** -0.5)
    v = v.astype(f32)
    ig = i_pre.astype(f32)
    logf = jax.nn.log_sigmoid(f_pre.astype(f32))

    def chunks(a):
        return a.reshape((B, nc, L) + a.shape[2:]).swapaxes(0, 1)

    causal = jnp.tril(jnp.ones((L, L), dtype=bool))

    def step(carry, inp):
        C, n, m = carry
        qc, kc, vc, ic, fc = inp
        bh = jnp.cumsum(fc, axis=1).transpose(0, 2, 1)
        ih = ic.transpose(0, 2, 1)
        dlog = jnp.where(causal, bh[:, :, :, None] - bh[:, :, None, :] + ih[:, :, None, :], -jnp.inf)
        inter = bh + m[:, :, None]
        mt = jnp.maximum(inter, jnp.max(dlog, axis=-1))
        a = jnp.exp(dlog - mt[..., None]) * jnp.einsum('bthd,bshd->bhts', qc, kc)
        w_inter = jnp.exp(inter - mt)
        num = (jnp.einsum('bhts,bshd->bthd', a, vc)
               + w_inter.transpose(0, 2, 1)[..., None] * jnp.einsum('bhkv,bthk->bthv', C, qc))
        den = jnp.sum(a, axis=-1) + w_inter * jnp.einsum('bhk,bthk->bht', n, qc)
        denom = jnp.maximum(jnp.abs(den), jnp.exp(-mt))
        h = num / denom.transpose(0, 2, 1)[..., None]
        bl = bh[:, :, -1]
        g = bl[:, :, None] - bh + ih
        m_new = jnp.maximum(bl + m, jnp.max(g, axis=-1))
        ws = jnp.exp(g - m_new[..., None])
        wc = jnp.exp(bl + m - m_new)
        C_new = wc[..., None, None] * C + jnp.einsum('bhs,bshk,bshv->bhkv', ws, kc, vc)
        n_new = wc[..., None] * n + jnp.einsum('bhs,bshk->bhk', ws, kc)
        return (C_new, n_new, m_new), h

    init = (C0.astype(f32), n0.astype(f32), m0.astype(f32))
    (Cf, nf, mf), hs = lax.scan(step, init, (chunks(q), chunks(k), chunks(v), chunks(ig), chunks(logf)))
    return hs.swapaxes(0, 1).reshape(B, S, H, D), Cf, nf, mf


def _layer(x, c, norm_g, ada_w, ada_b, w_in, qn_g, kn_g, sgu_g, sgu_w, sgu_b, conv_w, conv_b,
           f_bias, i_bias, hn_g, w_out, rel_bias,
           k_buf=None, v_buf=None, conv_buf=None, C0=None, n0=None, m0=None):
    B, S, _ = x.shape
    dt = x.dtype
    f32 = jnp.float32
    mod = jax.nn.silu(c.astype(f32)) @ ada_w.astype(f32) + ada_b.astype(f32)
    shift, scale, gate = jnp.split(mod, 3, axis=-1)
    h = (_rmsnorm(x, norm_g).astype(f32) * (1.0 + scale[:, None]) + shift[:, None]).astype(dt)
    proj = h @ w_in
    (q_a, k_a, v_a, z_a, u_b, v_b, z_b, qk_c, v_c, o_c, z_c, i_c, f_c) = jnp.split(proj, SPLIT_IDX, axis=-1)

    q = _rmsnorm(q_a.reshape(B, S, H_A, HEAD_DIM_A), qn_g) * (HEAD_DIM_A ** -0.5)
    k = _rmsnorm(k_a.reshape(B, S, H_A, HEAD_DIM_A), kn_g)
    v = v_a.reshape(B, S, H_A, HEAD_DIM_A)
    if k_buf is None:
        attn = _dilated_attn_prompt(q, k, v, rel_bias)
        wkeep = min(WIN_MAX, S)
        new_k, new_v = k[:, S - wkeep:], v[:, S - wkeep:]
    else:
        k_all = jnp.concatenate([k_buf.astype(k.dtype), k], axis=1)
        v_all = jnp.concatenate([v_buf.astype(v.dtype), v], axis=1)
        attn = _dilated_attn_sample(q, k_all, v_all, rel_bias, k_buf.shape[1])
        new_k, new_v = k, v
    y_a = attn.reshape(B, S, D_A).astype(dt) * jax.nn.silu(z_a)

    vn = _rmsnorm(v_b, sgu_g)
    y_b = _sgu(u_b, vn, sgu_w, sgu_b) * jax.nn.silu(z_b)

    if conv_buf is None:
        conv_buf = jnp.zeros((B, CONV_W - 1, 2 * D_C), dt)
    xp = jnp.concatenate([conv_buf.astype(qk_c.dtype), qk_c], axis=1)
    qk = conv_b
    for j in range(CONV_W):
        qk = qk + conv_w[j] * xp[:, j:j + S]
    q_c, k_c = jnp.split(jax.nn.silu(qk), 2, axis=-1)
    new_conv = xp[:, -(CONV_W - 1):]
    if C0 is None:
        C0 = jnp.zeros((B, H_C, DH_C, DH_C), f32)
        n0 = jnp.zeros((B, H_C, DH_C), f32)
        m0 = jnp.zeros((B, H_C), f32)
    hc, Cn, nn_, mn = _mlstm(q_c.reshape(B, S, H_C, DH_C), k_c.reshape(B, S, H_C, DH_C),
                             v_c.reshape(B, S, H_C, DH_C), i_c + i_bias, f_c + f_bias, C0, n0, m0)
    hc = _rmsnorm(hc, hn_g.reshape(H_C, DH_C))
    y_c = (hc.reshape(B, S, D_C) * jax.nn.sigmoid(o_c.astype(f32)) * jax.nn.silu(z_c.astype(f32))).astype(dt)

    y = jnp.concatenate([y_a, y_b, y_c], axis=-1) @ w_out
    x = x + (gate[:, None] * y.astype(f32)).astype(dt)
    return x, new_k, new_v, vn, new_conv, Cn, nn_, mn


def setup_inputs(seed: int = 0) -> dict:
    key = jax.random.key(seed)
    ks = jax.random.split(key, 26)
    f32 = jnp.float32

    def nrm(k, shape, s):
        return jax.random.normal(k, shape, f32) * s

    win_buf = min(WIN_MAX, PAST_LEN)
    ada_b = nrm(ks[13], (DEPTH, 3 * D_MODEL), 0.02).at[:, 2 * D_MODEL:].add(1.0)
    return {
        'x_prompt': nrm(ks[0], (BATCH, SEQ, D_MODEL), 1.0),
        'x_sample': nrm(ks[1], (DEC_BATCH, DEC_SEQ, D_MODEL), 1.0),
        'c_prompt': nrm(ks[2], (BATCH, D_MODEL), 1.0),
        'c_sample': nrm(ks[3], (DEC_BATCH, D_MODEL), 1.0),
        'cache_k_win': nrm(ks[4], (DEPTH, DEC_BATCH, win_buf, H_A, HEAD_DIM_A), 1.0),
        'cache_v_win': nrm(ks[5], (DEPTH, DEC_BATCH, win_buf, H_A, HEAD_DIM_A), 1.0),
        'state_conv': nrm(ks[6], (DEPTH, DEC_BATCH, CONV_W - 1, 2 * D_C), 1.0),
        'state_C': nrm(ks[7], (DEPTH, DEC_BATCH, H_C, DH_C, DH_C), 0.1),
        'state_n': nrm(ks[8], (DEPTH, DEC_BATCH, H_C, DH_C), 0.1),
        'state_m': nrm(ks[9], (DEPTH, DEC_BATCH, H_C), 1.0),
        'rel_bias': nrm(ks[10], (N_BUCKETS, H_A), 0.2),
        'norm_g': 1.0 + nrm(ks[11], (DEPTH, D_MODEL), 0.02),
        'ada_w': nrm(ks[12], (DEPTH, D_MODEL, 3 * D_MODEL), 0.1 * D_MODEL ** -0.5),
        'ada_b': ada_b,
        'w_in': nrm(ks[14], (DEPTH, D_MODEL, D_IN), D_MODEL ** -0.5),
        'qn_g': 1.0 + nrm(ks[15], (DEPTH, HEAD_DIM_A), 0.02),
        'kn_g': 1.0 + nrm(ks[16], (DEPTH, HEAD_DIM_A), 0.02),
        'sgu_g': 1.0 + nrm(ks[17], (DEPTH, D_B), 0.02),
        'sgu_w': nrm(ks[18], (DEPTH, G_B, CHUNK_B, CHUNK_B), CHUNK_B ** -0.5),
        'sgu_b': 1.0 + nrm(ks[19], (DEPTH, G_B, CHUNK_B), 0.02),
        'conv_w': nrm(ks[20], (DEPTH, CONV_W, 2 * D_C), CONV_W ** -0.5),
        'conv_b': nrm(ks[21], (DEPTH, 2 * D_C), 0.02),
        'f_bias': 3.0 + 3.0 * jax.random.uniform(ks[22], (DEPTH, H_C), f32),
        'i_bias': nrm(ks[23], (DEPTH, H_C), 0.1),
        'hn_g': 1.0 + nrm(ks[24], (DEPTH, D_C), 0.02),
        'w_out': nrm(ks[25], (DEPTH, D_MIX, D_MODEL), D_MIX ** -0.5),
    }


def reference(x_prompt, x_sample, c_prompt, c_sample, cache_k_win, cache_v_win, state_conv, state_C,
              state_n, state_m, rel_bias, norm_g, ada_w, ada_b, w_in, qn_g, kn_g, sgu_g, sgu_w, sgu_b,
              conv_w, conv_b, f_bias, i_bias, hn_g, w_out):
    xp, xs = x_prompt, x_sample
    p_k, p_v, p_conv, p_C, p_n, p_m = [], [], [], [], [], []
    s_k, s_v, s_sgu, s_conv, s_C, s_n, s_m = [], [], [], [], [], [], []
    for l in range(DEPTH):
        w = (norm_g[l], ada_w[l], ada_b[l], w_in[l], qn_g[l], kn_g[l], sgu_g[l], sgu_w[l], sgu_b[l],
             conv_w[l], conv_b[l], f_bias[l], i_bias[l], hn_g[l], w_out[l], rel_bias)
        xp, nk, nv, _, ncv, nC, nn_, nm = _layer(xp, c_prompt, *w)
        p_k.append(nk); p_v.append(nv); p_conv.append(ncv); p_C.append(nC); p_n.append(nn_); p_m.append(nm)
        xs, nk, nv, nsv, ncv, nC, nn_, nm = _layer(xs, c_sample, *w, cache_k_win[l], cache_v_win[l],
                                                  state_conv[l], state_C[l], state_n[l], state_m[l])
        s_k.append(nk); s_v.append(nv); s_sgu.append(nsv); s_conv.append(ncv)
        s_C.append(nC); s_n.append(nn_); s_m.append(nm)
    return (xp, xs,
            jnp.stack(p_k), jnp.stack(p_v), jnp.stack(p_conv), jnp.stack(p_C), jnp.stack(p_n), jnp.stack(p_m),
            jnp.stack(s_k), jnp.stack(s_v), jnp.stack(s_sgu), jnp.stack(s_conv), jnp.stack(s_C),
            jnp.stack(s_n), jnp.stack(s_m))
```

```cpp
#include <hip/hip_runtime.h>
#include <cstdio>
#include <cstdint>

#ifndef MK_N_LAUNCHES
#define MK_N_LAUNCHES 1
#endif

constexpr int D = 2048, SEQ = 4096, MP = 8192, MS = 64, MV = 8256, MPAD = 8448;
constexpr int DIN = 8460, NPROJ = 8448, NIN = 8704, DEPTH = 4;
constexpr int C_KA = 768, C_VA = 1536, C_ZA = 2304, C_UB = 3072, C_VB = 3584, C_ZB = 4096, C_QKC = 4608, C_VC = 6144, C_OC = 6912, C_ZC = 7680;
constexpr float EPS = 1e-6f;
constexpr size_t O_YP = 0, O_YS = 16777216, O_PK = O_YS + 131072, O_PV = O_PK + 12582912, O_PCONV = O_PV + 12582912, O_PC = O_PCONV + 36864,
                 O_PN = O_PC + 786432, O_PM = O_PN + 6144, O_SK = O_PM + 48, O_SV = O_SK + 196608, O_SGU = O_SV + 196608, O_SCONV = O_SGU + 131072,
                 O_SC = O_SCONV + 147456, O_SN = O_SC + 3145728, O_SM = O_SN + 24576, O_END = O_SM + 192;
constexpr size_t MiB = 1u << 20;
constexpr size_t WS_CTL = 0, CTL_ZERO_BYTES = 1 * MiB;
constexpr size_t WS_MOD = 1 * MiB;
constexpr size_t WS_BIAS = 2 * MiB;
constexpr size_t WS_GEFF = 4 * MiB;
constexpr size_t WS_SSQ = 5 * MiB;
constexpr size_t WS_GATES = 6 * MiB;
constexpr size_t WS_SCAL = 7 * MiB;
constexpr size_t WS_WIN = 8 * MiB;
constexpr size_t WS_WOUT = 144 * MiB;
constexpr size_t WS_A = 176 * MiB;
constexpr size_t WS_YMIX = 210 * MiB;
constexpr size_t WS_PROJ = 244 * MiB;
constexpr size_t WS_DC = 381 * MiB;
constexpr size_t WS_OA = 405 * MiB;
constexpr size_t WS_LA = 441 * MiB;
constexpr size_t WS_BT = 443 * MiB;
constexpr size_t WS_QC = 444 * MiB;
constexpr size_t WS_KC = 456 * MiB;
constexpr size_t WS_CB = 468 * MiB;
constexpr size_t WS_XB = 480 * MiB;
constexpr size_t WS_SGW = 512 * MiB;
constexpr size_t WS_END = 513 * MiB;
constexpr int CW_BAR = 4096;
constexpr int CW_Q = 8192;

constexpr int SCR_BYTES = 155648;
constexpr int LDSCTL_OFF = SCR_BYTES, LDS_BYTES = SCR_BYTES + 1024;

__constant__ unsigned char c_bucket[3][132] = {
{0,1,2,3,4,5,6,7,8,9,10,11,12,13,14,15,16,16,16,16,16,16,17,17,17,17,17,17,17,17,18,18,18,18,18,18,18,18,18,18,19,19,19,19,19,19,19,19,19,19,19,19,19,19,20,20,20,20,20,20,20,20,20,20,20,20,20,20,20,20,20,20,20,21,21,21,21,21,21,21,21,21,21,21,21,21,21,21,21,21,21,21,21,21,21,21,21,21,21,22,22,22,22,22,22,22,22,22,22,22,22,22,22,22,22,22,22,22,22,22,22,22,22,22,22,22,22,22,22,0,0,0},
{0,4,8,12,16,16,17,17,18,18,19,19,19,19,20,20,20,20,20,21,21,21,21,21,21,22,22,22,22,22,22,22,22,22,23,23,23,23,23,23,23,23,23,23,23,23,24,24,24,24,24,24,24,24,24,24,24,24,24,24,24,24,25,25,25,25,25,25,25,25,25,25,25,25,25,25,25,25,25,25,25,25,25,26,26,26,26,26,26,26,26,26,26,26,26,26,26,26,26,26,26,26,26,26,26,26,26,26,26,26,26,26,26,27,27,27,27,27,27,27,27,27,27,27,27,27,27,27,27,0,0,0},
{0,16,18,19,20,21,21,22,22,23,23,23,24,24,24,24,25,25,25,25,25,26,26,26,26,26,26,26,26,27,27,27,27,27,27,27,27,27,27,28,28,28,28,28,28,28,28,28,28,28,28,28,29,29,29,29,29,29,29,29,29,29,29,29,29,29,29,29,29,29,30,30,30,30,30,30,30,30,30,30,30,30,30,30,30,30,30,30,30,30,30,30,30,30,30,31,31,31,31,31,31,31,31,31,31,31,31,31,31,31,31,31,31,31,31,31,31,31,31,31,31,31,31,31,31,31,31,31,31,0,0,0}};

#define GAS __attribute__((address_space(1)))
#define LAS __attribute__((address_space(3)))
typedef unsigned short bf16_t;
typedef short bf16x8 __attribute__((ext_vector_type(8)));
typedef float f32x4 __attribute__((ext_vector_type(4)));
typedef unsigned u32x4 __attribute__((ext_vector_type(4)));
typedef unsigned u32x2 __attribute__((ext_vector_type(2)));
typedef float f32x16 __attribute__((ext_vector_type(16)));
typedef short v4i16_t __attribute__((ext_vector_type(4)));

__device__ __forceinline__ float bf2f(unsigned u) { return __uint_as_float(u << 16); }
typedef float f32x2_t __attribute__((ext_vector_type(2))); typedef __bf16 bf16x2_t __attribute__((ext_vector_type(2)));
__device__ __forceinline__ unsigned pk2(float lo, float hi) { const f32x2_t v = {lo, hi}; const bf16x2_t b = __builtin_convertvector(v, bf16x2_t); return __builtin_bit_cast(unsigned, b); }
__device__ __forceinline__ unsigned f2bf(float f) { return pk2(f, 0.f) & 0xffffu; }
__device__ __forceinline__ void st_wt16(void* p, u32x4 v) {
    unsigned long long* q = (unsigned long long*)p;
    __hip_atomic_store(q, (unsigned long long)v.x | ((unsigned long long)v.y << 32), __ATOMIC_RELAXED, __HIP_MEMORY_SCOPE_AGENT);
    __hip_atomic_store(q + 1, (unsigned long long)v.z | ((unsigned long long)v.w << 32), __ATOMIC_RELAXED, __HIP_MEMORY_SCOPE_AGENT);
}
__device__ __forceinline__ float siluf(float x) { return x / (1.f + __expf(-x)); }
__device__ __forceinline__ float sigmf(float x) { return 1.f / (1.f + __expf(-x)); }
__device__ __forceinline__ float logsigf(float x) { return fminf(x, 0.f) - log1pf(__expf(-fabsf(x))); }
__device__ __forceinline__ float wave_sum(float v) {
#pragma unroll
    for (int o = 1; o < 64; o <<= 1) v += __shfl_xor(v, o);
    return v;
}
__device__ __forceinline__ float wave_max(float v) {
#pragma unroll
    for (int o = 1; o < 64; o <<= 1) v = fmaxf(v, __shfl_xor(v, o));
    return v;
}
__device__ __forceinline__ float rdlane_f(float v, int l) { return __int_as_float(__builtin_amdgcn_readlane(__float_as_int(v), l)); }

struct Args { const float* in[26]; float* out; unsigned char* ws; int ph_lo, ph_hi; };
struct Frame;
struct Frame {
    unsigned char* lds;
    int tid, lane, wave, vcu, G, bx;
};
__device__ __forceinline__ int fresh_tid(const Frame& F) { int t = F.tid; asm volatile("" : "+v"(t)); return t; }
typedef const __attribute__((address_space(4))) Args* kargs_t;
__device__ __forceinline__ kargs_t KA() { kargs_t p = (kargs_t)__builtin_amdgcn_kernarg_segment_ptr(); asm volatile("" : "+s"(p)); return p; }
#define KIN(i) (KA()->in[i])
#define KOUT (KA()->out)
__device__ __forceinline__ float* wsf(size_t off) { return (float*)(KA()->ws + off); }
__device__ __forceinline__ bf16_t* wsh(size_t off) { return (bf16_t*)(KA()->ws + off); }
constexpr size_t WS_DN = WS_SCAL + 2 * 6 * 32 * 4 * 4;
constexpr size_t WS_NE = WS_DN + 12 * 32 * 128 * 4;
enum { I_XP = 0, I_XS, I_CP, I_CS, I_CK, I_CV, I_SCONV, I_SC, I_SN, I_SM, I_RELB, I_NORMG, I_ADAW, I_ADAB, I_WIN, I_QNG, I_KNG, I_SGUG, I_SGUW, I_SGUB, I_CONVW, I_CONVB, I_FB, I_IB, I_HNG, I_WOUT };

namespace pg8 {
constexpr int BM = 256, BK = 64, HALF = 128, HTB = HALF * BK * 2, STAGE_BYTES = 8 * HTB, NXCD = 8, WGM = 8;
__host__ __device__ __forceinline__ int lds_byte(int r, int c) { const int st = (r >> 4) * 2 + (c >> 5), rr = r & 15, cc = c & 31, ob = rr * 64 + cc * 2; return st * 1024 + (ob ^ (((ob >> 9) & 1) << 5)); }
__host__ __device__ __forceinline__ void stage_rc(int b, int& R, int& C) { const int st = b / 1024, sb = b % 1024, swz = sb ^ (((sb >> 9) & 1) << 5); R = (st >> 1) * 16 + swz / 64; C = (st & 1) * 32 + (swz % 64) / 2; }
__host__ __device__ __forceinline__ int perm32(int rho) { const int n = rho >> 4, i = rho & 15; return 8 * (i >> 2) + 4 * n + (i & 3); }

struct Unit { int pm, pn; };
struct Gemm { const bf16_t* A; const bf16_t* Bt; int M, N, K; };
struct StaticOrder {
    int nM, nN, nwg, G, c;
    __host__ __device__ void init(int M, int N, int G_, int c_) { nM = M / BM; nN = N / BM; nwg = nM * nN; G = G_; c = c_; }
    __host__ __device__ bool next(int i, Unit& u) const {
        const long L = (long)i * G + c; if (L >= nwg) return false;
        int wgid = (int)L; { const int q = nwg / NXCD, r = nwg % NXCD, xcd = wgid % NXCD, off = wgid / NXCD; wgid = (xcd < r ? xcd * (q + 1) : r * (q + 1) + (xcd - r) * q) + off; }
        const int nig = WGM * nN, gid = wgid / nig, fm = gid * WGM, gsz = (nM - fm) < WGM ? (nM - fm) : WGM;
        u.pm = fm + ((wgid % nig) % gsz); u.pn = (wgid % nig) / gsz; return true;
    }
    __device__ __forceinline__ void a_ready(const Unit&) const {}
    __device__ __forceinline__ void done(const Unit&) const {}
};

struct OrderIn : StaticOrder {
    int i0, i1;
    __device__ __forceinline__ bool next(int i, Unit& u) const {
        if (i0 + i >= i1) return false;
        if (!StaticOrder::next(i0 + i, u)) return false;
        u.pn = u.pn == 16 ? 9 : (u.pn == 9 ? 16 : (u.pn == 33 ? 10 : (u.pn == 10 ? 33 : u.pn)));
        return true;
    }
};

template <class Epi, class Sched>
__device__ __forceinline__ void gemm_phase(LAS unsigned char* lds, const Gemm g, const Sched& S, const Epi& E, const int tid) {
    const int wid = __builtin_amdgcn_readfirstlane(tid >> 6), lane = tid & 63, wr = wid >> 2, wc = wid & 3, fr = lane & 15, fq = lane >> 4;
    const int K = g.K, nt = K / BK;
    unsigned voffA[2], voffB[2];
#pragma unroll
    for (int i = 0; i < 2; ++i) { int R, C; stage_rc(tid * 16 + i * 8192, R, C); const int Rb = 64 * (R >> 5) + perm32(R & 31);
        voffA[i] = (unsigned)(R * K + C) * 2u; voffB[i] = (unsigned)(Rb * K + C) * 2u; }
    const size_t kstep = (size_t)(BK * 2);
    const size_t hstep = (size_t)HALF * K * 2;
    const size_t hstepB = (size_t)32 * K * 2;
    const size_t tstep = 2 * hstep;
    const unsigned ldsw = (unsigned)wid * 1024u;
    const int aoff = lds_byte(wr * 64 + fr, fq * 8), boff = lds_byte(wc * 32 + fr, fq * 8);
#define PG8_SA(b, h) (((b) * 2 + (h)) * HTB)
#define PG8_SB(b, h) ((4 + (b) * 2 + (h)) * HTB)
#define PG8_STAGE(bufoff, gbase, voff) do { _Pragma("unroll") for (int _i = 0; _i < 2; ++_i) \
        __builtin_amdgcn_global_load_lds((const unsigned*)((const char*)(gbase) + (voff)[_i]), (LAS unsigned*)(lds + (bufoff) + ldsw + _i * 8192), 16, 0, 0); } while (0)
#define PG8_LDA(dst, b, h) do { _Pragma("unroll") for (int m = 0; m < 4; ++m) _Pragma("unroll") for (int k = 0; k < 2; ++k) dst[m][k] = *(const LAS bf16x8*)(lds + PG8_SA(b, h) + aoff + m * 2048 + k * 1024); } while (0)
#define PG8_LDB(dst, b, h) do { _Pragma("unroll") for (int n = 0; n < 2; ++n) _Pragma("unroll") for (int k = 0; k < 2; ++k) dst[n][k] = *(const LAS bf16x8*)(lds + PG8_SB(b, h) + boff + n * 2048 + k * 1024); } while (0)
#define PG8_MMA(ai, bj, At, Bt) do { __builtin_amdgcn_s_setprio(1); _Pragma("unroll") for (int m = 0; m < 4; ++m) _Pragma("unroll") for (int n = 0; n < 2; ++n) _Pragma("unroll") for (int k = 0; k < 2; ++k) \
        acc[ai][bj][m][n] = __builtin_amdgcn_mfma_f32_16x16x32_bf16(Bt[n][k], At[m][k], acc[ai][bj][m][n], 0, 0, 0); __builtin_amdgcn_s_setprio(0); } while (0)
#define PG8_WAIT_V(n) asm volatile("s_waitcnt vmcnt(" #n ")" ::: "memory")
#define PG8_WAIT_L(n) asm volatile("s_waitcnt lgkmcnt(" #n ")" ::: "memory")
#define PG8_BAR __builtin_amdgcn_s_barrier()
#define PG8_SCHED __builtin_amdgcn_sched_barrier(0)
    Unit cur, nxt; int ui = 0;
    if (!S.next(0, cur)) return;
    f32x4 acc[2][2][4][2];
#pragma unroll
    for (int a = 0; a < 2; ++a)
#pragma unroll
        for (int b = 0; b < 2; ++b)
#pragma unroll
            for (int m = 0; m < 4; ++m)
#pragma unroll
                for (int n = 0; n < 2; ++n) acc[a][b][m][n] = (f32x4){0.f, 0.f, 0.f, 0.f};
    bf16x8 At[4][2], B0[2][2], B1[2][2];
    const char* cA = (const char*)g.A + (size_t)cur.pm * tstep; const char* cB = (const char*)g.Bt + (size_t)cur.pn * tstep;
    S.a_ready(cur);
    PG8_STAGE(PG8_SB(0, 0), cB, voffB); PG8_STAGE(PG8_SB(0, 1), cB + hstepB, voffB); PG8_STAGE(PG8_SA(0, 0), cA, voffA); PG8_STAGE(PG8_SA(0, 1), cA + hstep, voffA);
    if (wr == 1) PG8_BAR;
    PG8_WAIT_V(2); PG8_BAR;
    PG8_STAGE(PG8_SB(1, 0), cB + kstep, voffB); PG8_STAGE(PG8_SA(1, 0), cA + kstep, voffA); PG8_STAGE(PG8_SB(1, 1), cB + hstepB + kstep, voffB);
    PG8_WAIT_V(6); PG8_BAR;
    for (;;) {
        const bool has_next = S.next(ui + 1, nxt);
        const char* nA = has_next ? (const char*)g.A + (size_t)nxt.pm * tstep : cA; const char* nB = has_next ? (const char*)g.Bt + (size_t)nxt.pn * tstep : cB;
        for (int t = 0; t < nt; t += 2) {
            const bool last = (t == nt - 2);
            const char* a1 = cA + (size_t)(t + 1) * kstep;
            const char* a2 = last ? nA : cA + (size_t)(t + 2) * kstep; const char* b2 = last ? nB : cB + (size_t)(t + 2) * kstep;
            const char* a3 = a2 + kstep; const char* b3 = b2 + kstep;
            if (last && has_next) S.a_ready(nxt);
            PG8_LDB(B0, 0, 0); PG8_LDB(B1, 0, 1); PG8_SCHED; PG8_LDA(At, 0, 0); PG8_STAGE(PG8_SA(1, 1), a1 + hstep, voffA);
            PG8_WAIT_V(8); PG8_WAIT_L(0); PG8_BAR; PG8_MMA(0, 0, At, B0); PG8_MMA(0, 1, At, B1); PG8_BAR; PG8_SCHED;
            PG8_LDA(At, 0, 1); PG8_STAGE(PG8_SB(0, 0), b2, voffB); PG8_STAGE(PG8_SB(0, 1), b2 + hstepB, voffB); PG8_STAGE(PG8_SA(0, 0), a2, voffA);
            PG8_WAIT_V(8); PG8_WAIT_L(0); PG8_BAR; PG8_MMA(1, 0, At, B0); PG8_MMA(1, 1, At, B1); PG8_BAR; PG8_SCHED;
            PG8_LDB(B0, 1, 0); PG8_LDB(B1, 1, 1); PG8_SCHED; PG8_LDA(At, 1, 0); PG8_STAGE(PG8_SA(0, 1), a2 + hstep, voffA);
            PG8_WAIT_V(8); PG8_WAIT_L(0); PG8_BAR; PG8_MMA(0, 0, At, B0); PG8_MMA(0, 1, At, B1); PG8_BAR; PG8_SCHED;
            PG8_LDA(At, 1, 1); PG8_STAGE(PG8_SB(1, 0), b3, voffB); PG8_STAGE(PG8_SB(1, 1), b3 + hstepB, voffB); PG8_STAGE(PG8_SA(1, 0), a3, voffA);
            PG8_WAIT_V(8); PG8_WAIT_L(0); PG8_BAR; PG8_MMA(1, 0, At, B0); PG8_MMA(1, 1, At, B1); PG8_BAR; PG8_SCHED;
        }
        if (wr == 0) PG8_BAR;
        E(acc, cur, wr, wc, fr, fq); S.done(cur);
        if (!has_next) break;
#pragma unroll
        for (int a = 0; a < 2; ++a)
#pragma unroll
            for (int b = 0; b < 2; ++b)
#pragma unroll
                for (int m = 0; m < 4; ++m)
#pragma unroll
                    for (int n = 0; n < 2; ++n) acc[a][b][m][n] = (f32x4){0.f, 0.f, 0.f, 0.f};
        cur = nxt; cA = nA; cB = nB; ++ui;
        if (wr == 1) PG8_BAR;
    }
    PG8_WAIT_V(0);
    PG8_BAR;
#undef PG8_SA
#undef PG8_SB
#undef PG8_STAGE
#undef PG8_LDA
#undef PG8_LDB
#undef PG8_MMA
#undef PG8_WAIT_V
#undef PG8_WAIT_L
#undef PG8_BAR
#undef PG8_SCHED
}

struct EpiIn {
    int layer; int nostore;
    __device__ __forceinline__ void operator()(const f32x4 (&acc)[2][2][4][2], const Unit& u, int wr, int wc, int fr, int fq) const {
        if (nostore) { float s_ = 0.f;
#pragma unroll
            for (int a = 0; a < 2; ++a)
#pragma unroll
                for (int b = 0; b < 2; ++b)
#pragma unroll
                    for (int m = 0; m < 4; ++m)
#pragma unroll
                        for (int n = 0; n < 2; ++n) s_ += acc[a][b][m][n][0] + acc[a][b][m][n][1] + acc[a][b][m][n][2] + acc[a][b][m][n][3];
            if (s_ == 123.456f) wsf(WS_GATES)[0] = s_;
            return; }
        const int pn = u.pn, jb = u.pm >> 4;
        const int cb = pn * 256 + wc * 64 + fq * 8;
        const float* ssq = wsf(WS_SSQ) + (size_t)layer * MPAD + u.pm * 256 + wr * 64 + fr;
        const float* bp = wsf(WS_BIAS) + ((size_t)layer * 10 + jb) * NIN + cb;
        f32x4 bv[2][2]; float rs[2][4];
#pragma unroll
        for (int bj = 0; bj < 2; ++bj)
#pragma unroll
            for (int n = 0; n < 2; ++n) bv[bj][n] = *(const f32x4*)(bp + 32 * bj + 4 * n);
#pragma unroll
        for (int ai = 0; ai < 2; ++ai)
#pragma unroll
            for (int m = 0; m < 4; ++m) rs[ai][m] = ssq[ai * 128 + m * 16];
        f32x4 gq[2][2];
        if (pn < 6) { const float* gp = (pn < 3 ? KIN(I_QNG) : KIN(I_KNG)) + layer * 64 + fq * 8;
#pragma unroll
            for (int bj = 0; bj < 2; ++bj)
#pragma unroll
                for (int n = 0; n < 2; ++n) gq[bj][n] = *(const f32x4*)(gp + 32 * bj + 4 * n); }
        bf16_t* proj = wsh(WS_PROJ); float* out = KOUT;
#pragma unroll
        for (int ai = 0; ai < 2; ++ai)
#pragma unroll
            for (int m = 0; m < 4; ++m) {
                const int row = u.pm * 256 + ai * 128 + wr * 64 + m * 16 + fr;
                const float rstd = rsqrtf(rs[ai][m] * (1.f / 2048.f) + EPS);
                f32x4 v[2][2];
#pragma unroll
                for (int bj = 0; bj < 2; ++bj)
#pragma unroll
                    for (int n = 0; n < 2; ++n) v[bj][n] = acc[ai][bj][m][n] * rstd + bv[bj][n];
                if (pn < 6) {
                    float ss = 0.f;
#pragma unroll
                    for (int bj = 0; bj < 2; ++bj)
#pragma unroll
                        for (int n = 0; n < 2; ++n) { const f32x4 x = v[bj][n]; ss += (x[0] * x[0] + x[1] * x[1]) + (x[2] * x[2] + x[3] * x[3]); }
                    ss += __shfl_xor(ss, 16); ss += __shfl_xor(ss, 32);
                    const float r = rsqrtf(ss * (1.f / 64.f) + EPS) * (pn < 3 ? 0.125f * 1.4426950408889634f : 1.f);
#pragma unroll
                    for (int bj = 0; bj < 2; ++bj)
#pragma unroll
                        for (int n = 0; n < 2; ++n) v[bj][n] = v[bj][n] * r * gq[bj][n];
                }
                if (pn < 33) {
#pragma unroll
                    for (int bj = 0; bj < 2; ++bj) {
                        u32x4 w; w.x = pk2(v[bj][0][0], v[bj][0][1]); w.y = pk2(v[bj][0][2], v[bj][0][3]); w.z = pk2(v[bj][1][0], v[bj][1][1]); w.w = pk2(v[bj][1][2], v[bj][1][3]);
                        *(u32x4*)(proj + (size_t)row * NPROJ + cb + 32 * bj) = w;
                    }
                }
                float* dst = nullptr;
                const int t = row & 4095;
                if (pn >= 3 && pn < 9 && t >= 2048) dst = out + (pn < 6 ? O_PK : O_PV) + (size_t)((layer * 2 + jb) * 2048 + (t - 2048)) * 768 + (cb - (pn < 6 ? C_KA : C_VA));
                if (pn >= 18 && pn < 24 && t >= 4093) dst = out + O_PCONV + (size_t)((layer * 2 + jb) * 3 + (t - 4093)) * 1536 + (cb - C_QKC);
                if (dst) {
#pragma unroll
                    for (int bj = 0; bj < 2; ++bj)
#pragma unroll
                        for (int n = 0; n < 2; ++n) *(f32x4*)(dst + 32 * bj + 4 * n) = v[bj][n];
                }
                if (pn == 33 && wc == 0 && fq < 2) {
                    const float* ibias = KIN(I_IB) + layer * 6; const float* fbias = KIN(I_FB) + layer * 6; float* gates = wsf(WS_GATES);
#pragma unroll
                    for (int n = 0; n < 2; ++n)
#pragma unroll
                        for (int i = 0; i < 4; ++i) { const int gi = 8 * fq + 4 * n + i;
                            if (gi < 12) { float val = v[0][n][i]; if (gi < 6) val += ibias[gi]; else val = logsigf(val + fbias[gi - 6]); gates[(size_t)row * 16 + gi] = val; } }
                }
            }
    }
};

struct EpiOut {
    int layer; int nostore;
    __device__ __forceinline__ void operator()(const f32x4 (&acc)[2][2][4][2], const Unit& u, int wr, int wc, int fr, int fq) const {
        if (nostore) { float s_ = 0.f;
#pragma unroll
            for (int a = 0; a < 2; ++a)
#pragma unroll
                for (int b = 0; b < 2; ++b)
#pragma unroll
                    for (int m = 0; m < 4; ++m)
#pragma unroll
                        for (int n = 0; n < 2; ++n) s_ += acc[a][b][m][n][0] + acc[a][b][m][n][1] + acc[a][b][m][n][2] + acc[a][b][m][n][3];
            if (s_ == 123.456f) wsf(WS_GATES)[0] = s_;
            return; }
        const int jb = u.pm >> 4, cb = u.pn * 256 + wc * 64 + fq * 8;
        const bool nxt = layer + 1 < DEPTH, first = layer == 0;
        const float* xin = KIN(I_XP); bf16_t* xb = wsh(WS_XB); float* out = KOUT;
        const float* gp = wsf(WS_MOD) + ((size_t)layer * 10 + jb) * 6144 + 4096 + cb;
        const float* ge = wsf(WS_GEFF) + ((size_t)(nxt ? layer + 1 : layer) * 10 + jb) * D + cb;
        float* ssq_next = wsf(WS_SSQ) + (size_t)(layer + 1) * MPAD; bf16_t* Anext = wsh(WS_A);
        f32x4 gv[2][2], gev[2][2];
#pragma unroll
        for (int bj = 0; bj < 2; ++bj)
#pragma unroll
            for (int n = 0; n < 2; ++n) { gv[bj][n] = *(const f32x4*)(gp + 32 * bj + 4 * n); gev[bj][n] = *(const f32x4*)(ge + 32 * bj + 4 * n); }
#pragma unroll
        for (int am = 0; am < 4; ++am) {
            const int ai = am >> 1;
            f32x4 xr[4][2][2];
            if (first) {
#pragma unroll
                for (int m = 2 * (am & 1); m < 2 * (am & 1) + 2; ++m) { const size_t ro = (size_t)(u.pm * 256 + ai * 128 + wr * 64 + m * 16 + fr) * D + cb;
#pragma unroll
                    for (int bj = 0; bj < 2; ++bj)
#pragma unroll
                        for (int n = 0; n < 2; ++n) xr[m][bj][n] = *(const f32x4*)(xin + ro + 32 * bj + 4 * n); }
            } else {
                u32x4 xw[4][2];
#pragma unroll
                for (int m = 2 * (am & 1); m < 2 * (am & 1) + 2; ++m) { const size_t ro = (size_t)(u.pm * 256 + ai * 128 + wr * 64 + m * 16 + fr) * D + cb;
#pragma unroll
                    for (int bj = 0; bj < 2; ++bj) xw[m][bj] = *(const u32x4*)(xb + ro + 32 * bj); }
#pragma unroll
                for (int m = 2 * (am & 1); m < 2 * (am & 1) + 2; ++m)
#pragma unroll
                    for (int bj = 0; bj < 2; ++bj) { const u32x4 w = xw[m][bj];
                        xr[m][bj][0] = (f32x4){bf2f(w.x & 0xffffu), bf2f(w.x >> 16), bf2f(w.y & 0xffffu), bf2f(w.y >> 16)};
                        xr[m][bj][1] = (f32x4){bf2f(w.z & 0xffffu), bf2f(w.z >> 16), bf2f(w.w & 0xffffu), bf2f(w.w >> 16)}; }
            }
#pragma unroll
            for (int m = 2 * (am & 1); m < 2 * (am & 1) + 2; ++m) {
                const int row = u.pm * 256 + ai * 128 + wr * 64 + m * 16 + fr;
                float ss = 0.f;
#pragma unroll
                for (int bj = 0; bj < 2; ++bj) {
                    f32x4 xn[2];
#pragma unroll
                    for (int n = 0; n < 2; ++n) { xn[n] = xr[m][bj][n] + gv[bj][n] * acc[ai][bj][m][n];
                        ss += (xn[n][0] * xn[n][0] + xn[n][1] * xn[n][1]) + (xn[n][2] * xn[n][2] + xn[n][3] * xn[n][3]); }
                    if (nxt) {
                        u32x4 w; w.x = pk2(xn[0][0], xn[0][1]); w.y = pk2(xn[0][2], xn[0][3]); w.z = pk2(xn[1][0], xn[1][1]); w.w = pk2(xn[1][2], xn[1][3]);
                        *(u32x4*)(xb + (size_t)row * D + cb + 32 * bj) = w;
                        const f32x4 a0 = xn[0] * gev[bj][0], a1 = xn[1] * gev[bj][1];
                        w.x = pk2(a0[0], a0[1]); w.y = pk2(a0[2], a0[3]); w.z = pk2(a1[0], a1[1]); w.w = pk2(a1[2], a1[3]);
                        *(u32x4*)(Anext + (size_t)row * D + cb + 32 * bj) = w;
                    } else {
                        *(f32x4*)(out + (size_t)row * D + cb + 32 * bj) = xn[0]; *(f32x4*)(out + (size_t)row * D + cb + 32 * bj + 4) = xn[1];
                    }
                }
                if (nxt) { ss += __shfl_xor(ss, 16); ss += __shfl_xor(ss, 32); if (fq == 0) atomicAdd(ssq_next + row, ss); }
            }
        }
    }
};
}

#define XB_TMO      128
#define XB_XCNT(j)  (256  + 64 * (j))
#define XB_XSUB(j)  (1280 + 64 * (j))
#define XB_XGEN(j)  (2304 + 64 * (j))
#define XB_TOP      3328
#define XB_TOPGEN   3392
#define XCD_BAR_WORDS 3456
#define XB_SPIN_CAP (1u << 18)
__device__ __forceinline__ unsigned xb_ld(unsigned* p)              { return __hip_atomic_load(p, __ATOMIC_RELAXED, __HIP_MEMORY_SCOPE_AGENT); }
__device__ __forceinline__ unsigned xb_add(unsigned* p, unsigned v) { return __hip_atomic_fetch_add(p, v, __ATOMIC_RELAXED, __HIP_MEMORY_SCOPE_AGENT); }
__device__ __forceinline__ unsigned xb_xcc_id() { return (unsigned)__builtin_amdgcn_s_getreg((3 << 11) | 20) & 0xFu; }
#define XB_SPIN(cond, bar) do { unsigned _sp = 0; while (cond) { __builtin_amdgcn_s_sleep(1); \
    if ((++_sp & 255u) == 0u) { if (xb_ld(&(bar)[XB_TMO])) break; if (_sp > XB_SPIN_CAP) { atomicAdd(&(bar)[XB_TMO], 1u); break; } } } } while (0)
struct XcdBarrier { unsigned* bar; unsigned x; volatile LAS unsigned* st; };
__device__ __forceinline__ XcdBarrier xcd_barrier_post(unsigned* bar, volatile LAS unsigned* st) {
    XcdBarrier b; b.bar = bar; b.x = xb_xcc_id(); b.st = st;
    if (threadIdx.x == 0) (void)xb_add(&bar[XB_XCNT(b.x)], 1u);
    return b;
}
__device__ __forceinline__ void xcd_barrier_complete(unsigned* bar, unsigned x, unsigned& nloc, unsigned& nx) {
    const unsigned G = gridDim.x * gridDim.y * gridDim.z;
    unsigned sum, cnt, mine, sp = 0u;
    for (;;) {
        sum = 0u; cnt = 0u; mine = 0u;
#pragma unroll
        for (unsigned j = 0; j < 16; ++j) { const unsigned c = xb_ld(&bar[XB_XCNT(j)]); sum += c; cnt += (c > 0u) ? 1u : 0u; mine = (j == x) ? c : mine; }
        if (sum == G) break;
        __builtin_amdgcn_s_sleep(1);
        if ((++sp & 255u) == 0u) { if (xb_ld(&bar[XB_TMO])) break; if (sp > XB_SPIN_CAP) { atomicAdd(&bar[XB_TMO], 1u); break; } }
    }
    nloc = mine > 0u ? mine : 1u; nx = cnt > 0u ? cnt : 1u;
}
__device__ __forceinline__ void xcd_barrier(const XcdBarrier& b) {
    asm volatile("s_waitcnt vmcnt(0)" ::: "memory");
    __syncthreads();
    if (threadIdx.x == 0) {
        unsigned* bar = b.bar;
        __builtin_amdgcn_s_waitcnt(0);
        unsigned nloc = b.st[0], nx = b.st[1];
        if (nloc == 0u) { xcd_barrier_complete(bar, b.x, nloc, nx); b.st[0] = nloc; b.st[1] = nx; }
        const unsigned old = xb_add(&bar[XB_XSUB(b.x)], 1u);
        const unsigned gen = old / nloc;
        if (old + 1u == (gen + 1u) * nloc) {
            __builtin_amdgcn_fence(__ATOMIC_RELEASE, "agent");
            asm volatile("s_waitcnt vmcnt(0)" ::: "memory");
            const unsigned og = xb_add(&bar[XB_TOP], 1u);
            const unsigned tg = og / nx;
            if (og + 1u == (tg + 1u) * nx) xb_add(&bar[XB_TOPGEN], 1u);
            else XB_SPIN(xb_ld(&bar[XB_TOPGEN]) == tg, bar);
            __builtin_amdgcn_fence(__ATOMIC_ACQUIRE, "agent");
            xb_add(&bar[XB_XGEN(b.x)], 1u);
            asm volatile("s_waitcnt vmcnt(0)" ::: "memory");
        } else {
            XB_SPIN(xb_ld(&bar[XB_XGEN(b.x)]) == gen, bar);
            __builtin_amdgcn_fence(__ATOMIC_ACQUIRE, "agent");
            asm volatile("s_waitcnt vmcnt(0)" ::: "memory");
        }
    }
    __syncthreads();
}

__device__ __forceinline__ void gemv10_chunk(const float* W, int N, int n0, const float* tab, float* part, int wave, int lane, int tid,
                                             float* outp, int out_ld, const float* addv) {
    const int c8 = lane & 7, r0 = lane >> 3;
    const float* wp = W + (size_t)(wave * 256 + r0 * 32) * N + n0 + 4 * c8;
    const float* tp = tab + wave * 256 + r0 * 32;
    f32x4 acc[10];
#pragma unroll
    for (int j = 0; j < 10; ++j) acc[j] = (f32x4){0.f, 0.f, 0.f, 0.f};
#pragma unroll 1
    for (int b = 0; b < 2; ++b) {
        f32x4 w[16];
#pragma unroll
        for (int i = 0; i < 16; ++i) w[i] = *(const f32x4*)(wp + (size_t)(16 * b + i) * N);
#pragma unroll
        for (int j = 0; j < 10; ++j) {
            f32x4 a = acc[j];
#pragma unroll
            for (int i4 = 0; i4 < 4; ++i4) { const f32x4 t4 = *(const f32x4*)(tp + j * 2048 + 16 * b + 4 * i4);
                a += (w[4 * i4] * t4[0] + w[4 * i4 + 1] * t4[1]) + (w[4 * i4 + 2] * t4[2] + w[4 * i4 + 3] * t4[3]); }
            acc[j] = a;
            asm volatile("" ::: "memory");
        }
    }
#pragma unroll
    for (int j = 0; j < 10; ++j)
#pragma unroll
        for (int e = 0; e < 4; ++e) { float v = acc[j][e]; v += __shfl_xor(v, 8); v += __shfl_xor(v, 16); v += __shfl_xor(v, 32); acc[j][e] = v; }
    if (lane < 8) {
#pragma unroll
        for (int j = 0; j < 10; ++j) *(f32x4*)(part + (wave * 10 + j) * 32 + 4 * c8) = acc[j];
    }
    __syncthreads();
    if (tid < 320) {
        const int j = tid >> 5, c = tid & 31;
        float s = 0.f;
#pragma unroll
        for (int w = 0; w < 8; ++w) s += part[(w * 10 + j) * 32 + c];
        outp[(size_t)j * out_ld + n0 + c] = s + (addv ? addv[n0 + c] : 0.f);
    }
    __syncthreads();
}

struct TrItem { const float* W; bf16_t* WT; int N, k0, n0; };
__device__ __forceinline__ void tr_load(f32x4 (&v)[16], const TrItem& t, int lane) {
    const int col = t.n0 + 4 * (lane & 15); const bool cv = col < t.N;
    const float* p = t.W + (size_t)(t.k0 + (lane >> 4)) * t.N + (cv ? col : 0);
#pragma unroll
    for (int i = 0; i < 16; ++i) v[i] = cv ? *(const f32x4*)(p + (size_t)(4 * i) * t.N) : (f32x4){0.f, 0.f, 0.f, 0.f};
}
__device__ __forceinline__ void tr_store(const f32x4 (&v)[16], float* scr, const TrItem& t, int lane) {
    const int cg = lane & 15, r0 = lane >> 4;
#pragma unroll
    for (int i = 0; i < 16; ++i) { const int r = 4 * i + r0; *(f32x4*)(scr + r * 64 + 4 * (cg ^ (2 * (r >> 3)))) = v[i]; }
    asm volatile("s_waitcnt lgkmcnt(0)" ::: "memory");
    const int c = lane & 7;
#pragma unroll
    for (int j = 0; j < 8; ++j) { const int n = (lane >> 3) + 8 * j; const float* s = scr + (8 * c) * 64 + 4 * ((n >> 2) ^ (2 * c)) + (n & 3);
        u32x4 o; o.x = pk2(s[0 * 64], s[1 * 64]); o.y = pk2(s[2 * 64], s[3 * 64]); o.z = pk2(s[4 * 64], s[5 * 64]); o.w = pk2(s[6 * 64], s[7 * 64]);
        *(u32x4*)(t.WT + (size_t)(t.n0 + n) * D + t.k0 + 8 * c) = o; }
    asm volatile("s_waitcnt lgkmcnt(0)" ::: "memory");
}
template <class Map>
__device__ __forceinline__ void transpose_run(Frame& F, int it0, int step, int NT, const Map& map) {
    float* scr = (float*)(F.lds + F.wave * 16384);
    int it = it0; if (it >= NT) return;
    f32x4 v[16]; TrItem c = map(it); tr_load(v, c, F.lane);
    for (;;) {
        const int nx = it + step; const bool hn = nx < NT;
        f32x4 w[16]; TrItem n_ = c;
        if (hn) { n_ = map(nx); tr_load(w, n_, F.lane); }
        tr_store(v, scr, c, F.lane);
        if (!hn) break;
#pragma unroll
        for (int i = 0; i < 16; ++i) v[i] = w[i];
        c = n_; it = nx;
    }
}
constexpr int WT_IN = 32 * 133, WT_OUT = 32 * 32;
struct MapIn { int l; __device__ __forceinline__ TrItem operator()(int it) const { const int kb = it / 133, nb = it - kb * 133;
    return TrItem{KIN(I_WIN) + (size_t)l * D * DIN, wsh(WS_WIN) + (size_t)l * NIN * D, DIN, 64 * kb, 64 * nb}; } };
struct MapAll { __device__ __forceinline__ TrItem operator()(int it) const { const int l = it / (WT_IN + WT_OUT), r = it - l * (WT_IN + WT_OUT);
    if (r < WT_IN) return MapIn{l}(r);
    const int q = r - WT_IN; return TrItem{KIN(I_WOUT) + (size_t)l * D * D, wsh(WS_WOUT) + (size_t)l * D * D, D, 64 * (q >> 5), 64 * (q & 31)}; } };

__device__ __forceinline__ void phase_p0(Frame& F) {
    float* tab = (float*)F.lds;
    float* part = (float*)(F.lds + 81920);
    { const float* cp = KIN(I_CP); const float* cs = KIN(I_CS);
      for (int o = F.tid; o < 10 * 2048; o += 512) { const int j = o >> 11, k = o & 2047; const float c = j < 2 ? cp[j * D + k] : cs[(j - 2) * D + k]; tab[o] = siluf(c); } }
    __syncthreads();
    for (int it = F.bx; it < DEPTH * 192; it += F.G) {
        const int l = it / 192, ch = it % 192;
        gemv10_chunk(KIN(I_ADAW) + (size_t)l * D * 6144, 6144, ch * 32, tab, part, F.wave, F.lane, F.tid, wsf(WS_MOD) + (size_t)l * 10 * 6144, 6144, KIN(I_ADAB) + (size_t)l * 6144);
    }
    __syncthreads();
    const int gw = F.vcu * 8 + F.wave, NGW = F.G * 8;
    transpose_run(F, gw, NGW, DEPTH * (WT_IN + WT_OUT), MapAll{});
    const int gt = F.bx * 512 + F.tid, NGT = F.G * 512;
    for (int l = 0; l < DEPTH; ++l) { u32x4* p = (u32x4*)(wsh(WS_WIN) + ((size_t)l * NIN + 8480) * D); for (int o = gt; o < 224 * D / 8; o += NGT) p[o] = (u32x4){0u, 0u, 0u, 0u}; }
    { float* bz = wsf(WS_BIAS); for (int o = gt; o < DEPTH * 10 * NIN; o += NGT) bz[o] = 0.f; }
    { float* sz = wsf(WS_SSQ); for (int o = gt; o < 5 * MPAD; o += NGT) sz[o] = 0.f; }
    { float* btab = wsf(WS_BT); const float* relb = KIN(I_RELB); const float* qg = KIN(I_QNG); const float* kg = KIN(I_KNG);
      for (int it = gw; it < DEPTH * 12; it += NGW) { const int l = it / 12, h = it % 12;
          const float G = wave_max(fabsf(qg[l * 64 + F.lane] * kg[l * 64 + F.lane]));
          const float mb_ = wave_max(relb[(F.lane & 31) * 12 + h]);
          const float M = 8.f * G + mb_;
          for (int o = F.lane; o < 3 * 132; o += 64) { const int p = o / 132, j = o % 132;
              btab[(size_t)((l * 3 + p) * 12 + h) * 132 + j] = j <= 128 ? (relb[(int)c_bucket[p][j] * 12 + h] - M) * 1.4426950408889634f : 0.f; } } }
    { const float* sw = KIN(I_SGUW); bf16_t* sg16 = wsh(WS_SGW); for (int o = gt; o < DEPTH * 4 * 128 * 128; o += NGT) { const int s_ = o & 127, t_ = (o >> 7) & 127; sg16[o] = (bf16_t)f2bf(s_ <= t_ ? sw[o] : 0.f); } }
}

__device__ __forceinline__ void bias_unit(Frame& F, int layer, int unit) {
    const int tid = fresh_tid(F), lane = tid & 63, wave = __builtin_amdgcn_readfirstlane(tid >> 6), hh = lane >> 5, l31 = lane & 31;
    const int n0 = unit * 64;
    const float* sh = wsf(WS_MOD) + ((size_t)layer * 10 + (l31 < 10 ? l31 : 0)) * 6144 + wave * 256 + 8 * hh;
    float* part = (float*)F.lds;
    f32x16 acc[2];
#pragma unroll
    for (int b = 0; b < 2; ++b)
#pragma unroll
        for (int i = 0; i < 16; ++i) acc[b][i] = 0.f;
    unsigned char* stg = F.lds + wave * 8192;
    const int lr = lane >> 3, lp = lane & 7;
    const bf16_t* bsrc = wsh(WS_WIN) + ((size_t)layer * NIN + n0 + lr) * D + wave * 256 + lp * 8;
    u32x4 sreg[8];
#pragma unroll
    for (int i = 0; i < 8; ++i) sreg[i] = *(const u32x4*)(bsrc + (size_t)(8 * i) * D);
    __syncthreads();
#pragma unroll 1
    for (int kb = 0; kb < 4; ++kb) {
#pragma unroll
        for (int i = 0; i < 8; ++i) { const int r = 8 * i + lr; *(u32x4*)(stg + r * 128 + ((lp ^ ((r >> 1) & 7)) << 4)) = sreg[i]; }
        if (kb < 3) {
#pragma unroll
            for (int i = 0; i < 8; ++i) sreg[i] = *(const u32x4*)(bsrc + (size_t)(8 * i) * D + 64 * (kb + 1));
        }
#pragma unroll
        for (int k4 = 0; k4 < 4; ++k4) { const int ko = (kb * 4 + k4) * 16;
            u32x4 pw = (u32x4){0u, 0u, 0u, 0u};
            if (l31 < 10) { const f32x4 s0 = *(const f32x4*)(sh + ko), s1 = *(const f32x4*)(sh + ko + 4); pw.x = pk2(s0[0], s0[1]); pw.y = pk2(s0[2], s0[3]); pw.z = pk2(s1[0], s1[1]); pw.w = pk2(s1[2], s1[3]); }
            const bf16x8 a = __builtin_bit_cast(bf16x8, pw);
#pragma unroll
            for (int ct = 0; ct < 2; ++ct) { const int rb = 32 * ct + l31;
                const bf16x8 b = *(const bf16x8*)(stg + rb * 128 + (((2 * k4 + hh) ^ ((rb >> 1) & 7)) << 4));
                acc[ct] = __builtin_amdgcn_mfma_f32_32x32x16_bf16(a, b, acc[ct], 0, 0, 0); }
        }
        asm volatile("s_waitcnt lgkmcnt(0)" ::: "memory");
    }
    __syncthreads();
#pragma unroll
    for (int ct = 0; ct < 2; ++ct)
#pragma unroll
        for (int i = 0; i < 16; ++i) part[(wave * 32 + (i & 3) + 8 * (i >> 2) + 4 * hh) * 68 + 32 * ct + l31] = acc[ct][i];
    __syncthreads();
    for (int o = tid; o < 640; o += 512) { const int j = o >> 6, c = o & 63; float v = 0.f;
#pragma unroll
        for (int w = 0; w < 8; ++w) v += part[(w * 32 + j) * 68 + c];
        wsf(WS_BIAS)[((size_t)layer * 10 + j) * NIN + n0 + c] = v; }
}

__device__ __forceinline__ void bias_unit_fast(Frame& F, int layer, int unit) {
    const int tid = fresh_tid(F), lane = tid & 63, wave = __builtin_amdgcn_readfirstlane(tid >> 6), hh = lane >> 5, l31 = lane & 31;
    const int n0 = unit * 64;
    const float* sh = wsf(WS_MOD) + ((size_t)layer * 10 + (l31 < 10 ? l31 : 0)) * 6144 + wave * 256 + 8 * hh;
    float* part = (float*)F.lds;
    unsigned char* stg = F.lds + wave * 16384;
    const int lr = lane >> 3, lp = lane & 7;
    const bf16_t* bsrc = wsh(WS_WIN) + ((size_t)layer * NIN + n0 + lr) * D + wave * 256 + lp * 8;
    u32x4 sa[16], sb[16], pw[16];
#pragma unroll
    for (int kb = 0; kb < 4; ++kb)
#pragma unroll
        for (int i = 0; i < 4; ++i) sa[kb * 4 + i] = *(const u32x4*)(bsrc + (size_t)(8 * i) * D + 64 * kb);
#pragma unroll
    for (int k = 0; k < 16; ++k) { pw[k] = (u32x4){0u, 0u, 0u, 0u};
        if (l31 < 10) { const f32x4 s0 = *(const f32x4*)(sh + 16 * k), s1 = *(const f32x4*)(sh + 16 * k + 4); pw[k].x = pk2(s0[0], s0[1]); pw[k].y = pk2(s0[2], s0[3]); pw[k].z = pk2(s1[0], s1[1]); pw[k].w = pk2(s1[2], s1[3]); } }
#pragma unroll
    for (int kb = 0; kb < 4; ++kb)
#pragma unroll
        for (int i = 0; i < 4; ++i) sb[kb * 4 + i] = *(const u32x4*)(bsrc + (size_t)(32 + 8 * i) * D + 64 * kb);
    f32x16 acc[2];
#pragma unroll
    for (int c = 0; c < 2; ++c)
#pragma unroll
        for (int i = 0; i < 16; ++i) acc[c][i] = 0.f;
    __syncthreads();
#pragma unroll
    for (int ct = 0; ct < 2; ++ct) {
#pragma unroll
        for (int kb = 0; kb < 4; ++kb)
#pragma unroll
            for (int i = 0; i < 4; ++i) { const int r = 8 * i + lr; *(u32x4*)(stg + kb * 4096 + r * 128 + ((lp ^ ((r >> 1) & 7)) << 4)) = ct ? sb[kb * 4 + i] : sa[kb * 4 + i]; }
        asm volatile("s_waitcnt lgkmcnt(0)" ::: "memory");
#pragma unroll
        for (int k = 0; k < 16; ++k) {
            const bf16x8 a = __builtin_bit_cast(bf16x8, pw[k]);
            const bf16x8 b = *(const bf16x8*)(stg + (k >> 2) * 4096 + l31 * 128 + (((2 * (k & 3) + hh) ^ ((l31 >> 1) & 7)) << 4));
            acc[ct] = __builtin_amdgcn_mfma_f32_32x32x16_bf16(a, b, acc[ct], 0, 0, 0);
        }
        asm volatile("s_waitcnt lgkmcnt(0)" ::: "memory");
    }
    __syncthreads();
#pragma unroll
    for (int ct = 0; ct < 2; ++ct)
#pragma unroll
        for (int i = 0; i < 16; ++i) part[(wave * 32 + (i & 3) + 8 * (i >> 2) + 4 * hh) * 68 + 32 * ct + l31] = acc[ct][i];
    __syncthreads();
    for (int o = tid; o < 640; o += 512) { const int j = o >> 6, c = o & 63; float v = 0.f;
#pragma unroll
        for (int w = 0; w < 8; ++w) v += part[(w * 32 + j) * 68 + c];
        wsf(WS_BIAS)[((size_t)layer * 10 + j) * NIN + n0 + c] = v; }
}

__device__ __forceinline__ void phase_p1(Frame& F, bool dynamic) {
    const int gt = F.bx * 512 + F.tid, NGT = F.G * 512;
    { float* geff = wsf(WS_GEFF); const float* mod = wsf(WS_MOD); const float* ng = KIN(I_NORMG);
      for (int o = gt; o < DEPTH * 10 * D; o += NGT) { const int k = o & 2047, lj = o >> 11, l = lj / 10; geff[o] = ng[l * D + k] * (1.f + mod[(size_t)lj * 6144 + 2048 + k]); } }
    const int gw = F.vcu * 8 + F.wave, NGW = F.G * 8;
    const float* xp_ = KIN(I_XP); const float* xs_ = KIN(I_XS); const float* mod0 = wsf(WS_MOD); const float* ng = KIN(I_NORMG); bf16_t* Ab = wsh(WS_A); float* ssq0 = wsf(WS_SSQ);
    const int NB1 = (F.G == 256) ? 5 : 133;
    const int U_BIAS = 133 + (DEPTH - 1) * NB1; constexpr int U_ROWS = MV / 32; const int U_TOT = U_BIAS + U_ROWS;
    unsigned* ctr = (unsigned*)(KA()->ws + WS_CTL) + CW_Q + 64 * 40;
    volatile unsigned* slot = (volatile unsigned*)(F.lds + LDSCTL_OFF + 64);
    unsigned pre = 0u;
    if (dynamic) { if (F.tid == 0) pre = __hip_atomic_fetch_add(ctr, 1u, __ATOMIC_RELAXED, __HIP_MEMORY_SCOPE_AGENT); } else pre = (unsigned)F.bx;
    for (;;) {
        unsigned uq;
        if (dynamic) { __syncthreads(); if (F.tid == 0) slot[0] = pre; __syncthreads(); uq = slot[0]; if (uq >= (unsigned)U_TOT) break;
            if (F.tid == 0) pre = __hip_atomic_fetch_add(ctr, 1u, __ATOMIC_RELAXED, __HIP_MEMORY_SCOPE_AGENT); }
        else { uq = pre; if (uq >= (unsigned)U_TOT) break; pre += (unsigned)F.G; }
        if (uq < (unsigned)U_BIAS) { if (uq < 133u) bias_unit_fast(F, 0, (int)uq); else { const int r_ = (int)uq - 133; bias_unit_fast(F, 1 + r_ / NB1, 133 - NB1 + r_ % NB1); } continue; }
    {
        const int row0 = ((int)uq - U_BIAS) * 32 + F.wave * 4;
        const int jb = row0 < MP ? (row0 >> 12) : 2 + ((row0 - MP) >> 3);
        const float* xr = row0 < MP ? xp_ + (size_t)row0 * D : xs_ + (size_t)(row0 - MP) * D;
        const float* sc = mod0 + (size_t)jb * 6144 + 2048;
        f32x4 x[4][8];
#pragma unroll
        for (int r = 0; r < 4; ++r)
#pragma unroll
            for (int i = 0; i < 8; ++i) x[r][i] = *(const f32x4*)(xr + (size_t)r * D + (i * 64 + F.lane) * 4);
        float ss[4] = {0.f, 0.f, 0.f, 0.f};
#pragma unroll
        for (int i = 0; i < 8; ++i) {
            const int c = (i * 64 + F.lane) * 4;
            const f32x4 s = *(const f32x4*)(sc + c), g = *(const f32x4*)(ng + c);
            const f32x4 ge = g * (s + 1.f);
#pragma unroll
            for (int r = 0; r < 4; ++r) { const f32x4 xv = x[r][i];
                ss[r] += (xv[0] * xv[0] + xv[1] * xv[1]) + (xv[2] * xv[2] + xv[3] * xv[3]);
                const f32x4 a = xv * ge;
                u32x2 w; w.x = pk2(a[0], a[1]); w.y = pk2(a[2], a[3]);
                *(u32x2*)(Ab + (size_t)(row0 + r) * D + c) = w; }
        }
#pragma unroll
        for (int r = 0; r < 4; ++r) { const float t_ = wave_sum(ss[r]); if (F.lane == 0) ssq0[row0 + r] = t_; }
    }
    }
    __syncthreads();
}

__device__ __forceinline__ void sattn_item(Frame& F, int layer, int it) {
    const int tid = fresh_tid(F), lane = tid & 63, wave = __builtin_amdgcn_readfirstlane(tid >> 6);
    const int t = it & 7, bhh = it >> 3, h = bhh % 12, bs = bhh / 12;
    const int mb = MP + bs * 8, m = mb + t, grp = lane >> 4, dl = lane & 15;
    const bf16_t* P = wsh(WS_PROJ);
    float* wsc = (float*)(F.lds + wave * 4096);
    { const float* relb = KIN(I_RELB);
#pragma unroll
      for (int i = 0; i < 7; ++i) { const int e = lane + 64 * i; if (e < 387) { const int p = (e >= 129) + (e >= 258), j = e - 129 * p; wsc[e] = relb[(int)c_bucket[p][j] * 12 + h] * 1.4426950408889634f; } } }
    const float* ck = KIN(I_CK) + ((size_t)(layer * 8 + bs) * 2048) * 768 + h * 64 + dl * 4;
    const float* cvp = KIN(I_CV) + ((size_t)(layer * 8 + bs) * 2048) * 768 + h * 64 + dl * 4;
    const bf16_t* pk = P + (size_t)mb * NPROJ + C_KA + h * 64 + dl * 4;
    const bf16_t* pv = P + (size_t)mb * NPROJ + C_VA + h * 64 + dl * 4;
    float q0, q1, q2, q3;
    { const u32x2 w = *(const u32x2*)(P + (size_t)m * NPROJ + h * 64 + dl * 4); q0 = bf2f(w.x & 0xffffu); q1 = bf2f(w.x >> 16); q2 = bf2f(w.y & 0xffffu); q3 = bf2f(w.y >> 16); }
    float m_run = -INFINITY, l_run = 0.f; f32x4 o = (f32x4){0.f, 0.f, 0.f, 0.f};
#pragma unroll 1
    for (int i0 = 0; i0 < 112; i0 += 16) {
        f32x4 kv[16], vv[16];
#pragma unroll
        for (int ii = 0; ii < 16; ++ii) {
            int e = 4 * (i0 + ii) + grp; e = e > 386 ? 386 : e;
            const int p = (e >= 129) + (e >= 258), j = e - 129 * p, tk = 2048 + t - (j << (2 * p));
            if (tk < 2048) { kv[ii] = *(const f32x4*)(ck + (size_t)tk * 768); vv[ii] = *(const f32x4*)(cvp + (size_t)tk * 768); }
            else { const u32x2 w = *(const u32x2*)(pk + (size_t)(tk - 2048) * NPROJ), x = *(const u32x2*)(pv + (size_t)(tk - 2048) * NPROJ);
                kv[ii] = (f32x4){bf2f(w.x & 0xffffu), bf2f(w.x >> 16), bf2f(w.y & 0xffffu), bf2f(w.y >> 16)}; vv[ii] = (f32x4){bf2f(x.x & 0xffffu), bf2f(x.x >> 16), bf2f(x.y & 0xffffu), bf2f(x.y >> 16)}; }
        }
        float sc[16]; float cm = -INFINITY;
#pragma unroll
        for (int ii = 0; ii < 16; ++ii) {
            float s_ = q0 * kv[ii][0] + q1 * kv[ii][1] + q2 * kv[ii][2] + q3 * kv[ii][3];
            s_ += __shfl_xor(s_, 1); s_ += __shfl_xor(s_, 2); s_ += __shfl_xor(s_, 4); s_ += __shfl_xor(s_, 8);
            const int e = 4 * (i0 + ii) + grp;
            sc[ii] = e < 387 ? s_ + wsc[e] : -INFINITY; cm = fmaxf(cm, sc[ii]);
        }
        const float mn = fmaxf(m_run, cm);
        const float scale = __builtin_amdgcn_exp2f(m_run - mn);
        l_run *= scale; o = o * scale;
#pragma unroll
        for (int ii = 0; ii < 16; ++ii) { const float pe = __builtin_amdgcn_exp2f(sc[ii] - mn); l_run += pe; o += vv[ii] * pe; }
        m_run = mn;
    }
    { float M = fmaxf(m_run, __shfl_xor(m_run, 16)); M = fmaxf(M, __shfl_xor(M, 32));
      const float f = __builtin_amdgcn_exp2f(m_run - M); l_run *= f; o = o * f;
      l_run += __shfl_xor(l_run, 16); l_run += __shfl_xor(l_run, 32);
#pragma unroll
      for (int c = 0; c < 4; ++c) { float x = o[c]; x += __shfl_xor(x, 16); x += __shfl_xor(x, 32); o[c] = x; } }
    if (grp == 0) {
        const u32x2 zw = *(const u32x2*)(P + (size_t)m * NPROJ + C_ZA + h * 64 + dl * 4);
        const float il = 1.f / l_run;
        u32x2 y; y.x = pk2(o[0] * il * siluf(bf2f(zw.x & 0xffffu)), o[1] * il * siluf(bf2f(zw.x >> 16))); y.y = pk2(o[2] * il * siluf(bf2f(zw.y & 0xffffu)), o[3] * il * siluf(bf2f(zw.y >> 16)));
        *(u32x2*)(wsh(WS_YMIX) + (size_t)m * D + h * 64 + dl * 4) = y;
    }
}

__device__ __forceinline__ v4i16_t lds_tr16(const unsigned char* p) { return __builtin_amdgcn_ds_read_tr16_b64_v4i16((LAS v4i16_t*)p); }
__device__ __forceinline__ bf16x8 tr_frag_nat(const unsigned char* img, int ld, int k0, int n0, int lane) {
    const int g4 = lane >> 4, c0 = 16 * (g4 & 1), hh = g4 >> 1, q4 = (lane & 15) >> 2, p4 = lane & 3;
    const unsigned char* p = img + (k0 + 8 * hh + q4) * ld + (n0 + c0 + 4 * p4) * 2;
    const v4i16_t a = lds_tr16(p), b = lds_tr16(p + 4 * ld);
    return (bf16x8){a[0], a[1], a[2], a[3], b[0], b[1], b[2], b[3]};
}
__device__ __forceinline__ bf16x8 tr_frag_acc(const unsigned char* img, int ld, int k0, int n0, int lane) {
    const int g4 = lane >> 4, c0 = 16 * (g4 & 1), hh = g4 >> 1, q4 = (lane & 15) >> 2, p4 = lane & 3;
    const unsigned char* p = img + (k0 + 4 * hh + q4) * ld + (n0 + c0 + 4 * p4) * 2;
    const v4i16_t a = lds_tr16(p), b = lds_tr16(p + 8 * ld);
    return (bf16x8){a[0], a[1], a[2], a[3], b[0], b[1], b[2], b[3]};
}
__device__ __forceinline__ bf16x8 pack_acc8(const f32x16& x, int s2) {
    u32x4 pw; pw.x = pk2(x[8 * s2 + 0], x[8 * s2 + 1]); pw.y = pk2(x[8 * s2 + 2], x[8 * s2 + 3]); pw.z = pk2(x[8 * s2 + 4], x[8 * s2 + 5]); pw.w = pk2(x[8 * s2 + 6], x[8 * s2 + 7]);
    return __builtin_bit_cast(bf16x8, pw);
}
__device__ __forceinline__ void wave_cumsum128(float* arr, int lane) {
    const float a = arr[2 * lane], b = arr[2 * lane + 1], s = a + b; float inc = s;
#pragma unroll
    for (int o = 1; o < 64; o <<= 1) { const float t = __shfl_up(inc, o); if (lane >= o) inc += t; }
    const float exc = inc - s; arr[2 * lane] = exc + a; arr[2 * lane + 1] = exc + s;
}
__device__ __forceinline__ void wave_cummax128(float* arr, int lane) {
    const float a = arr[2 * lane], b = arr[2 * lane + 1], s = fmaxf(a, b); float inc = s;
#pragma unroll
    for (int o = 1; o < 64; o <<= 1) { const float t = __shfl_up(inc, o); if (lane >= o) inc = fmaxf(inc, t); }
    float exc = __shfl_up(inc, 1); if (lane == 0) exc = -INFINITY;
    arr[2 * lane] = fmaxf(exc, a); arr[2 * lane + 1] = fmaxf(exc, s);
}
constexpr int IMG_LD = 320;

struct AttnHalf { u32x4 k[2], v[2], qv[2]; };
__device__ __forceinline__ void attn_issue(AttnHalf& R, const bf16_t* P, int mb, int h, int dil, int r, int n, int tid, bool with_q) {
#pragma unroll
    for (int it = 0; it < 2; ++it) {
        const int pid = it * 512 + tid, row = pid >> 3, ch = pid & 7;
        const bf16_t* rp = P + (size_t)(mb + (n * 128 + row) * dil + r) * NPROJ + h * 64 + ch * 8;
        R.k[it] = *(const u32x4*)(rp + C_KA); R.v[it] = *(const u32x4*)(rp + C_VA);
        if (with_q) R.qv[it] = *(const u32x4*)(rp);
    }
}
__device__ __forceinline__ void attn_put(unsigned char* half, const AttnHalf& R, int tid) {
#pragma unroll
    for (int it = 0; it < 2; ++it) { const int pid = it * 512 + tid, row = pid >> 3, ch = pid & 7;
        *(u32x4*)(half + row * 128 + ((ch ^ ((row >> 1) & 7)) << 4)) = R.k[it];
        *(u32x4*)(half + 16384 + row * 128 + ch * 16) = R.v[it]; }
}
template <int PAR>
__device__ __forceinline__ void attn_unit(unsigned char* lds0, const bf16_t* P, AttnHalf& R, int layer, int p, int mb, int h, int dil, int r, int n, int n_pre,
                                          int tid, int lane, int qt, int kh, int q, int hh) {
    unsigned char* up = lds0 + PAR * 32768; unsigned char* lo = lds0 + (PAR ^ 1) * 32768;
    unsigned char* qimg = lds0 + 116736;
    const float* bt2 = (const float*)(lds0 + 65536);
    float* part = (float*)(lds0 + 66560); float* partl = part + 4 * 16 * 2 * 64;
    unsigned char* ost = lds0 + 100352 + qt * 4096;
    __syncthreads();
    attn_put(up, R, tid);
#pragma unroll
    for (int it = 0; it < 2; ++it) { const int pid = it * 512 + tid, row = pid >> 3, ch = pid & 7; *(u32x4*)(qimg + row * 128 + ((ch ^ ((row >> 1) & 7)) << 4)) = R.qv[it]; }
    __syncthreads();
    if (n_pre >= 0) attn_issue(R, P, mb, h, dil, r, n_pre, tid, true);
    bf16x8 qf[4];
    { const int qrow = 32 * qt + q;
#pragma unroll
      for (int s_ = 0; s_ < 4; ++s_) qf[s_] = *(const bf16x8*)(qimg + qrow * 128 + (((2 * s_ + hh) ^ ((qrow >> 1) & 7)) << 4)); }
    f32x16 o0, o1;
#pragma unroll
    for (int e = 0; e < 16; ++e) { o0[e] = 0.f; o1[e] = 0.f; }
    float lsum = 0.f;
#pragma unroll
    for (int k3 = 0; k3 < 3; ++k3) {
        const int kk = kh ? 3 + k3 : k3;
        if (kh && k3 == 2) continue;
        const int kt = qt + kk;
        if (n == 0 && kt < 4) continue;
        const unsigned char* hb = kt < 4 ? lo : up;
        f32x16 st;
#pragma unroll
        for (int e = 0; e < 16; ++e) st[e] = bt2[160 - 32 * kk + q - ((e & 3) + 8 * (e >> 2) + 4 * hh)];
        const int krow = 32 * (kt & 3) + q;
#pragma unroll
        for (int s_ = 0; s_ < 4; ++s_) {
            const bf16x8 kf = *(const bf16x8*)(hb + krow * 128 + (((2 * s_ + hh) ^ ((krow >> 1) & 7)) << 4));
            st = __builtin_amdgcn_mfma_f32_32x32x16_bf16(kf, qf[s_], st, 0, 0, 0);
        }
#pragma unroll
        for (int e = 0; e < 16; ++e) { const float pe = __builtin_amdgcn_exp2f(st[e]); lsum += pe; st[e] = pe; }
#pragma unroll
        for (int s2 = 0; s2 < 2; ++s2) {
            const bf16x8 pa = pack_acc8(st, s2);
            const bf16x8 v0 = tr_frag_acc(hb + 16384, 128, 32 * (kt & 3) + 16 * s2, 0, lane), v1 = tr_frag_acc(hb + 16384, 128, 32 * (kt & 3) + 16 * s2, 32, lane);
            o0 = __builtin_amdgcn_mfma_f32_32x32x16_bf16(pa, v0, o0, 0, 0, 0);
            o1 = __builtin_amdgcn_mfma_f32_32x32x16_bf16(pa, v1, o1, 0, 0, 0);
        }
    }
    lsum += __shfl_xor(lsum, 32);
    if (kh) {
#pragma unroll
        for (int e = 0; e < 16; ++e) { part[((qt * 16 + e) * 2 + 0) * 64 + lane] = o0[e]; part[((qt * 16 + e) * 2 + 1) * 64 + lane] = o1[e]; }
        partl[qt * 64 + lane] = lsum;
    }
    __syncthreads();
    if (!kh) {
#pragma unroll
        for (int e = 0; e < 16; ++e) { o0[e] += part[((qt * 16 + e) * 2 + 0) * 64 + lane]; o1[e] += part[((qt * 16 + e) * 2 + 1) * 64 + lane]; }
        lsum += partl[qt * 64 + lane];
        const int mq = mb + ((n * 128 + 32 * qt + q) * dil + r);
        if (hh == 0) wsf(WS_LA)[((size_t)p * MP + mq) * 12 + h] = lsum;
#pragma unroll
        for (int e = 0; e < 16; ++e) {
            const int qq = (e & 3) + 8 * (e >> 2) + 4 * hh;
            *(bf16_t*)(ost + qq * 128 + q * 2) = (bf16_t)f2bf(o0[e]); *(bf16_t*)(ost + qq * 128 + 64 + q * 2) = (bf16_t)f2bf(o1[e]);
        }
        asm volatile("s_waitcnt lgkmcnt(0)" ::: "memory");
        const int qq = lane >> 1, half = lane & 1;
        bf16_t* op = wsh(WS_OA) + (size_t)p * MP * 768 + (size_t)(mb + r + (n * 128 + 32 * qt + qq) * dil) * 768 + h * 64 + half * 32;
#pragma unroll
        for (int e = 0; e < 4; ++e) *(u32x4*)(op + 8 * e) = *(const u32x4*)(ost + qq * 128 + half * 64 + 16 * e);
    }
}
constexpr int ATT_JOBS = 24 * 32;
__device__ __forceinline__ void attn_job(Frame& F, int layer, int job) {
    const int tid = fresh_tid(F), lane = tid & 63, wave = __builtin_amdgcn_readfirstlane(tid >> 6), qt = wave & 3, kh = wave >> 2, q = lane & 31, hh = lane >> 5;
    const int bh = job < 384 ? (job >> 4) : ((job - 384) >> 4), jj = job < 384 ? (job & 15) : 16 + ((job - 384) & 15), h = bh % 12, b = bh / 12, mb = b * SEQ;
    int p, r, n0, len;
    if (jj < 8) { p = 0; r = 0; n0 = 4 * jj; len = 4; } else if (jj < 16) { p = 1; r = (jj - 8) >> 1; n0 = 4 * (jj & 1); len = 4; } else { p = 2; r = jj - 16; n0 = 0; len = 2; }
    const int dil = 1 << (2 * p);
    float* bt = (float*)(F.lds + 65536);
    const bf16_t* P = wsh(WS_PROJ);
    AttnHalf RA, RB;
    attn_issue(RA, P, mb, h, dil, r, n0, tid, true);
    attn_issue(RB, P, mb, h, dil, r, n0 + 1, tid, true);
    __syncthreads();
    if (tid < 192) { const int j = tid - 32; bt[tid] = (j >= 0 && j <= 128) ? wsf(WS_BT)[(size_t)((layer * 3 + p) * 12 + h) * 132 + j] : -INFINITY; }
    if (n0 > 0) { AttnHalf RL; attn_issue(RL, P, mb, h, dil, r, n0 - 1, tid, false); attn_put(F.lds + 32768, RL, tid); }
#pragma unroll 1
    for (int i = 0; i < len; i += 2) {
        attn_unit<0>(F.lds, P, RA, layer, p, mb, h, dil, r, n0 + i, i + 2 < len ? n0 + i + 2 : -1, tid, lane, qt, kh, q, hh);
        attn_unit<1>(F.lds, P, RB, layer, p, mb, h, dil, r, n0 + i + 1, i + 3 < len ? n0 + i + 3 : -1, tid, lane, qt, kh, q, hh);
    }
    __syncthreads();
}
__device__ __forceinline__ void attn_combine_row(Frame& F, int m) {
    const bf16_t* OA = wsh(WS_OA); const float* LA = wsf(WS_LA); const bf16_t* P = wsh(WS_PROJ); bf16_t* Y = wsh(WS_YMIX);
    u32x2 o0[3], o1[3], o2[3], zz[3]; float L[3];
#pragma unroll
    for (int i = 0; i < 3; ++i) {
        const int c = (F.lane + 64 * i) * 4, hd = c >> 6;
        o0[i] = *(const u32x2*)(OA + (size_t)m * 768 + c); o1[i] = *(const u32x2*)(OA + ((size_t)MP + m) * 768 + c); o2[i] = *(const u32x2*)(OA + ((size_t)2 * MP + m) * 768 + c);
        zz[i] = *(const u32x2*)(P + (size_t)m * NPROJ + C_ZA + c);
        L[i] = LA[(size_t)m * 12 + hd] + LA[((size_t)MP + m) * 12 + hd] + LA[((size_t)2 * MP + m) * 12 + hd];
    }
#pragma unroll
    for (int i = 0; i < 3; ++i) {
        const int c = (F.lane + 64 * i) * 4; const float il = 1.f / L[i];
        const float a0 = (bf2f(o0[i].x & 0xffffu) + bf2f(o1[i].x & 0xffffu) + bf2f(o2[i].x & 0xffffu)) * il * siluf(bf2f(zz[i].x & 0xffffu));
        const float a1 = (bf2f(o0[i].x >> 16) + bf2f(o1[i].x >> 16) + bf2f(o2[i].x >> 16)) * il * siluf(bf2f(zz[i].x >> 16));
        const float a2 = (bf2f(o0[i].y & 0xffffu) + bf2f(o1[i].y & 0xffffu) + bf2f(o2[i].y & 0xffffu)) * il * siluf(bf2f(zz[i].y & 0xffffu));
        const float a3 = (bf2f(o0[i].y >> 16) + bf2f(o1[i].y >> 16) + bf2f(o2[i].y >> 16)) * il * siluf(bf2f(zz[i].y >> 16));
        u32x2 y; y.x = pk2(a0, a1); y.y = pk2(a2, a3);
        *(u32x2*)(Y + (size_t)m * D + c) = y;
    }
}

__device__ __forceinline__ void sgu_unit(Frame& F, int layer, int m0, int L, int g, float* sgu_out  ) {
    float* Wt = (float*)F.lds;
    float* vn = (float*)(F.lds + 65536);
    float* rs = (float*)(F.lds + 131072);
    const bf16_t* P = wsh(WS_PROJ); bf16_t* Y = wsh(WS_YMIX); const int tid = fresh_tid(F);
    __syncthreads();
    { const int r = tid >> 2, sub = tid & 3;
      float ss = 0.f;
      if (r < L) { const bf16_t* vp = P + (size_t)(m0 + r) * NPROJ + C_VB + sub * 128;
          for (int c = 0; c < 128; c += 8) { const u32x4 w = *(const u32x4*)(vp + c);
              const float a0 = bf2f(w.x & 0xffffu), a1 = bf2f(w.x >> 16), a2 = bf2f(w.y & 0xffffu), a3 = bf2f(w.y >> 16), a4 = bf2f(w.z & 0xffffu), a5 = bf2f(w.z >> 16), a6 = bf2f(w.w & 0xffffu), a7 = bf2f(w.w >> 16);
              ss += a0 * a0 + a1 * a1 + a2 * a2 + a3 * a3 + a4 * a4 + a5 * a5 + a6 * a6 + a7 * a7; } }
      ss += __shfl_xor(ss, 1); ss += __shfl_xor(ss, 2);
      if (r < L && sub == 0) rs[r] = rsqrtf(ss * (1.f / 512.f) + EPS); }
    __syncthreads();
    const float* sw = KIN(I_SGUW) + ((size_t)(layer * 4 + g)) * 128 * 128;
    const float* sg = KIN(I_SGUG) + layer * 512 + g * 128;
    for (int o = tid; o < L * 128; o += 512) {
        const int s = o >> 7, c = o & 127;
        const float v = bf2f(P[(size_t)(m0 + s) * NPROJ + C_VB + g * 128 + c]) * rs[s] * sg[c];
        vn[o] = v;
        if (sgu_out) sgu_out[(size_t)s * 512 + g * 128 + c] = v;
    }
    for (int o = tid; o < L * 128; o += 512) { const int t = o >> 7, s = o & 127; Wt[o] = (s <= t && s < L) ? sw[t * 128 + s] : 0.f; }
    __syncthreads();
    const int c = tid & 127, tq = tid >> 7;
    const float* sb = KIN(I_SGUB) + (layer * 4 + g) * 128;
    for (int t = tq; t < L; t += 4) {
        float acc = 0.f;
        for (int s = 0; s <= t; ++s) acc += Wt[t * 128 + s] * vn[s * 128 + c];
        const float mix = acc + sb[t];
        const size_t pr = (size_t)(m0 + t) * NPROJ;
        const float u = bf2f(P[pr + C_UB + g * 128 + c]), z = bf2f(P[pr + C_ZB + g * 128 + c]);
        Y[(size_t)(m0 + t) * D + 768 + g * 128 + c] = (bf16_t)f2bf(u * mix * siluf(z));
    }
    __syncthreads();
}

__device__ __forceinline__ void sgu_unit_mfma(Frame& F, int layer, int m0, int g) {
    unsigned char* vimg = F.lds;
    float* hbuf = (float*)(F.lds + 40960);
    const bf16_t* P = wsh(WS_PROJ); const int tid = fresh_tid(F), lane = tid & 63, wave = __builtin_amdgcn_readfirstlane(tid >> 6);
    const int r = tid >> 2, sub = tid & 3;
    const bf16_t* vp = P + (size_t)(m0 + r) * NPROJ + C_VB + sub * 128;
    const int tt = wave & 3, ct0 = (wave >> 2) * 2, tl = lane & 31, hh = lane >> 5, t = 32 * tt + tl;
    bf16x8 wf[4][2];
    { const bf16_t* sw = wsh(WS_SGW) + ((size_t)(layer * 4 + g)) * 128 * 128 + (size_t)t * 128 + 8 * hh;
#pragma unroll
      for (int st = 0; st < 4; ++st) if (st <= tt) {
#pragma unroll
          for (int s2 = 0; s2 < 2; ++s2) wf[st][s2] = *(const bf16x8*)(sw + 32 * st + 16 * s2); } }
    float ss = 0.f;
#pragma unroll
    for (int c = 0; c < 16; ++c) { const u32x4 w = *(const u32x4*)(vp + 8 * c);
        const float a0 = bf2f(w.x & 0xffffu), a1 = bf2f(w.x >> 16), a2 = bf2f(w.y & 0xffffu), a3 = bf2f(w.y >> 16), a4 = bf2f(w.z & 0xffffu), a5 = bf2f(w.z >> 16), a6 = bf2f(w.w & 0xffffu), a7 = bf2f(w.w >> 16);
        ss += a0 * a0 + a1 * a1 + a2 * a2 + a3 * a3 + a4 * a4 + a5 * a5 + a6 * a6 + a7 * a7; }
    ss += __shfl_xor(ss, 1); ss += __shfl_xor(ss, 2);
    const float rr = rsqrtf(ss * (1.f / 512.f) + EPS);
    __syncthreads();
    if (sub == g) {
#pragma unroll
        for (int c = 0; c < 16; ++c) { const u32x4 w = *(const u32x4*)(vp + 8 * c); u32x4 o;
            o.x = pk2(bf2f(w.x & 0xffffu) * rr, bf2f(w.x >> 16) * rr); o.y = pk2(bf2f(w.y & 0xffffu) * rr, bf2f(w.y >> 16) * rr);
            o.z = pk2(bf2f(w.z & 0xffffu) * rr, bf2f(w.z >> 16) * rr); o.w = pk2(bf2f(w.w & 0xffffu) * rr, bf2f(w.w >> 16) * rr);
            *(u32x4*)(vimg + r * IMG_LD + c * 16) = o; } }
    __syncthreads();
    {   f32x16 a0, a1;
#pragma unroll
        for (int i = 0; i < 16; ++i) { a0[i] = 0.f; a1[i] = 0.f; }
#pragma unroll
        for (int st = 0; st < 4; ++st) if (st <= tt) {
#pragma unroll
            for (int s2 = 0; s2 < 2; ++s2) {
                const bf16x8 af = wf[st][s2];
                const bf16x8 b0 = tr_frag_nat(vimg, IMG_LD, 32 * st + 16 * s2, 32 * ct0, lane), b1 = tr_frag_nat(vimg, IMG_LD, 32 * st + 16 * s2, 32 * ct0 + 32, lane);
                a0 = __builtin_amdgcn_mfma_f32_32x32x16_bf16(af, b0, a0, 0, 0, 0);
                a1 = __builtin_amdgcn_mfma_f32_32x32x16_bf16(af, b1, a1, 0, 0, 0);
            }
        }
#pragma unroll
        for (int i = 0; i < 16; ++i) { const int tr_ = 32 * tt + (i & 3) + 8 * (i >> 2) + 4 * hh;
            hbuf[tr_ * 132 + 32 * ct0 + tl] = a0[i]; hbuf[tr_ * 132 + 32 * ct0 + 32 + tl] = a1[i]; }
    }
    const int tp = tid >> 2, part = tid & 3;
    const bf16_t* pu = P + (size_t)(m0 + tp) * NPROJ + C_UB + g * 128 + part * 32; const bf16_t* pz = P + (size_t)(m0 + tp) * NPROJ + C_ZB + g * 128 + part * 32;
    const float* sg = KIN(I_SGUG) + layer * 512 + g * 128 + part * 32;
    const float bv = KIN(I_SGUB)[(layer * 4 + g) * 128 + tp];
    u32x4 uwv[4], zwv[4]; f32x4 gv[8];
#pragma unroll
    for (int i = 0; i < 4; ++i) { uwv[i] = *(const u32x4*)(pu + 8 * i); zwv[i] = *(const u32x4*)(pz + 8 * i); gv[2 * i] = *(const f32x4*)(sg + 8 * i); gv[2 * i + 1] = *(const f32x4*)(sg + 8 * i + 4); }
    __syncthreads();
    {   bf16_t* py = wsh(WS_YMIX) + (size_t)(m0 + tp) * D + 768 + g * 128 + part * 32;
#pragma unroll
        for (int i = 0; i < 4; ++i) {
            const u32x4 uw = uwv[i], zw = zwv[i];
            const f32x4 a = *(const f32x4*)(hbuf + tp * 132 + part * 32 + 8 * i) * gv[2 * i] + bv, c = *(const f32x4*)(hbuf + tp * 132 + part * 32 + 8 * i + 4) * gv[2 * i + 1] + bv;
            u32x4 y;
            y.x = pk2(bf2f(uw.x & 0xffffu) * a[0] * siluf(bf2f(zw.x & 0xffffu)), bf2f(uw.x >> 16) * a[1] * siluf(bf2f(zw.x >> 16)));
            y.y = pk2(bf2f(uw.y & 0xffffu) * a[2] * siluf(bf2f(zw.y & 0xffffu)), bf2f(uw.y >> 16) * a[3] * siluf(bf2f(zw.y >> 16)));
            y.z = pk2(bf2f(uw.z & 0xffffu) * c[0] * siluf(bf2f(zw.z & 0xffffu)), bf2f(uw.z >> 16) * c[1] * siluf(bf2f(zw.z >> 16)));
            y.w = pk2(bf2f(uw.w & 0xffffu) * c[2] * siluf(bf2f(zw.w & 0xffffu)), bf2f(uw.w >> 16) * c[3] * siluf(bf2f(zw.w >> 16)));
            *(u32x4*)(py + 8 * i) = y;
        }
    }
    __syncthreads();
}

struct ConvP { const bf16_t* proj; const float* cw; const float* cb; const float* sconv; };
__device__ __forceinline__ ConvP conv_ptrs(int layer) { ConvP c; c.proj = wsh(WS_PROJ); c.cw = KIN(I_CONVW) + (size_t)layer * 4 * 1536; c.cb = KIN(I_CONVB) + layer * 1536; c.sconv = KIN(I_SCONV) + (size_t)layer * 8 * 3 * 1536; return c; }
template <bool SAMPLE>
__device__ __forceinline__ float conv_qk(const ConvP& cp, int mbase, int bs, int t, int col) {
    const float* cw = cp.cw + col;
    float a = cp.cb[col];
#pragma unroll
    for (int j = 0; j < 4; ++j) {
        const int tt = t - 3 + j; float x;
        if (tt >= 0) x = bf2f(cp.proj[(size_t)(mbase + tt) * NPROJ + C_QKC + col]);
        else x = SAMPLE ? cp.sconv[((size_t)bs * 3 + (tt + 3)) * 1536 + col] : 0.f;
        a += cw[j * 1536] * x;
    }
    return siluf(a);
}

__device__ __forceinline__ void m1_unit(Frame& F, int layer, int u) {
    const int n = u & 31, bh = u >> 5, h = bh % 6, b = bh / 6, tid = fresh_tid(F), lane = tid & 63, wave = __builtin_amdgcn_readfirstlane(tid >> 6);
    const int mbase = b * SEQ, t0 = n * 128, m0 = mbase + t0;
    unsigned char* kimg = F.lds; unsigned char* vimg = F.lds + 40960;
    float* ws = (float*)(F.lds + 81920); float* dnp = ws + 128;
    const bf16_t* P = wsh(WS_PROJ);
    const int cg = tid & 15, rg = tid >> 4, colq = h * 128 + cg * 8, colk = 768 + colq;
    u32x4 vreg[4];
#pragma unroll
    for (int i = 0; i < 4; ++i) { const int pid = i * 512 + tid, row = pid >> 4, ch = pid & 15; vreg[i] = *(const u32x4*)(P + (size_t)(m0 + row) * NPROJ + C_VC + h * 128 + ch * 8); }
    u32x4 xq[7], xk[7];
#pragma unroll
    for (int i = 0; i < 7; ++i) { const int tt = t0 + 4 * rg - 3 + i;
        xq[i] = (u32x4){0u, 0u, 0u, 0u}; xk[i] = (u32x4){0u, 0u, 0u, 0u};
        if (tt >= 0) { const bf16_t* rp = P + (size_t)(mbase + tt) * NPROJ + C_QKC; xq[i] = *(const u32x4*)(rp + colq); xk[i] = *(const u32x4*)(rp + colk); } }
    const float* cwl = KIN(I_CONVW) + (size_t)layer * 4 * 1536; const float* cbl = KIN(I_CONVB) + layer * 1536;
    f32x4 wq[4][2], wk[4][2], bq[2], bk[2];
#pragma unroll
    for (int j = 0; j < 4; ++j) { wq[j][0] = *(const f32x4*)(cwl + j * 1536 + colq); wq[j][1] = *(const f32x4*)(cwl + j * 1536 + colq + 4); wk[j][0] = *(const f32x4*)(cwl + j * 1536 + colk); wk[j][1] = *(const f32x4*)(cwl + j * 1536 + colk + 4); }
    bq[0] = *(const f32x4*)(cbl + colq); bq[1] = *(const f32x4*)(cbl + colq + 4); bk[0] = *(const f32x4*)(cbl + colk); bk[1] = *(const f32x4*)(cbl + colk + 4);
    float ig0 = 0.f, ig1 = 0.f, lf0 = 0.f, lf1 = 0.f;
    if (wave == 0) { const float* GT = wsf(WS_GATES) + (size_t)(m0 + 2 * lane) * 16; ig0 = GT[h]; lf0 = GT[6 + h]; ig1 = GT[16 + h]; lf1 = GT[16 + 6 + h]; }
    __syncthreads();
    if (wave == 0) {
        const float sp = lf0 + lf1; float inc = sp;
#pragma unroll
        for (int o = 1; o < 64; o <<= 1) { const float t = __shfl_up(inc, o); if (lane >= o) inc += t; }
        const float c0 = inc - sp + lf0, c1 = inc;
        const float bl = rdlane_f(c1, 63);
        const float g0 = bl - c0 + ig0, g1 = bl - c1 + ig1;
        const float gm = wave_max(fmaxf(g0, g1));
        ws[2 * lane] = __expf(g0 - gm); ws[2 * lane + 1] = __expf(g1 - gm);
        if (lane == 0) { float* SCp = wsf(WS_SCAL); SCp[(size_t)u * 4 + 0] = gm; SCp[(size_t)u * 4 + 1] = bl; }
    }
#pragma unroll
    for (int i = 0; i < 4; ++i) { const int pid = i * 512 + tid, row = pid >> 4, ch = pid & 15; *(u32x4*)(vimg + row * IMG_LD + ch * 16) = vreg[i]; }
    float kc[4][8];
    {   bf16_t* QCb = wsh(WS_QC) + (size_t)(m0 + 4 * rg) * 768 + colq; bf16_t* KCb = wsh(WS_KC) + (size_t)(m0 + 4 * rg) * 768 + colq;
#pragma unroll
        for (int rr = 0; rr < 4; ++rr) {
            float a[8], c[8];
#pragma unroll
            for (int e = 0; e < 8; ++e) { a[e] = bq[e >> 2][e & 3]; c[e] = bk[e >> 2][e & 3]; }
#pragma unroll
            for (int j = 0; j < 4; ++j) { const u32x4 x = xq[rr + j], y = xk[rr + j];
                a[0] += wq[j][0][0] * bf2f(x.x & 0xffffu); a[1] += wq[j][0][1] * bf2f(x.x >> 16); a[2] += wq[j][0][2] * bf2f(x.y & 0xffffu); a[3] += wq[j][0][3] * bf2f(x.y >> 16);
                a[4] += wq[j][1][0] * bf2f(x.z & 0xffffu); a[5] += wq[j][1][1] * bf2f(x.z >> 16); a[6] += wq[j][1][2] * bf2f(x.w & 0xffffu); a[7] += wq[j][1][3] * bf2f(x.w >> 16);
                c[0] += wk[j][0][0] * bf2f(y.x & 0xffffu); c[1] += wk[j][0][1] * bf2f(y.x >> 16); c[2] += wk[j][0][2] * bf2f(y.y & 0xffffu); c[3] += wk[j][0][3] * bf2f(y.y >> 16);
                c[4] += wk[j][1][0] * bf2f(y.z & 0xffffu); c[5] += wk[j][1][1] * bf2f(y.z >> 16); c[6] += wk[j][1][2] * bf2f(y.w & 0xffffu); c[7] += wk[j][1][3] * bf2f(y.w >> 16); }
#pragma unroll
            for (int e = 0; e < 8; ++e) { a[e] = siluf(a[e]); kc[rr][e] = siluf(c[e]) * 0.08838834764831845f; }
            u32x4 o; o.x = pk2(a[0], a[1]); o.y = pk2(a[2], a[3]); o.z = pk2(a[4], a[5]); o.w = pk2(a[6], a[7]);
            *(u32x4*)(QCb + (size_t)rr * 768) = o;
            o.x = pk2(kc[rr][0], kc[rr][1]); o.y = pk2(kc[rr][2], kc[rr][3]); o.z = pk2(kc[rr][4], kc[rr][5]); o.w = pk2(kc[rr][6], kc[rr][7]);
            *(u32x4*)(KCb + (size_t)rr * 768) = o;
        }
    }
    __syncthreads();
    {   float dsum[8];
#pragma unroll
        for (int e = 0; e < 8; ++e) dsum[e] = 0.f;
#pragma unroll
        for (int rr = 0; rr < 4; ++rr) { const int s = 4 * rg + rr; const float wv = ws[s];
            u32x4 ow; ow.x = pk2(kc[rr][0] * wv, kc[rr][1] * wv); ow.y = pk2(kc[rr][2] * wv, kc[rr][3] * wv); ow.z = pk2(kc[rr][4] * wv, kc[rr][5] * wv); ow.w = pk2(kc[rr][6] * wv, kc[rr][7] * wv);
            *(u32x4*)(kimg + s * IMG_LD + cg * 16) = ow;
#pragma unroll
            for (int e = 0; e < 8; ++e) dsum[e] += kc[rr][e] * wv; }
#pragma unroll
        for (int e = 0; e < 8; ++e) { float x = dsum[e]; x += __shfl_xor(x, 16); x += __shfl_xor(x, 32); dsum[e] = x; }
        if ((lane >> 4) == 0) {
#pragma unroll
            for (int e = 0; e < 8; ++e) dnp[wave * 128 + cg * 8 + e] = dsum[e]; }
    }
    __syncthreads();
    {
        const int kt = wave >> 1, vt0 = 2 * (wave & 1);
        f32x16 d0, d1;
#pragma unroll
        for (int i = 0; i < 16; ++i) { d0[i] = 0.f; d1[i] = 0.f; }
#pragma unroll
        for (int ks = 0; ks < 8; ++ks) {
            const bf16x8 af = tr_frag_nat(kimg, IMG_LD, 16 * ks, 32 * kt, lane);
            const bf16x8 b0 = tr_frag_nat(vimg, IMG_LD, 16 * ks, 32 * vt0, lane), b1 = tr_frag_nat(vimg, IMG_LD, 16 * ks, 32 * vt0 + 32, lane);
            d0 = __builtin_amdgcn_mfma_f32_32x32x16_bf16(af, b0, d0, 0, 0, 0);
            d1 = __builtin_amdgcn_mfma_f32_32x32x16_bf16(af, b1, d1, 0, 0, 0);
        }
        float* dc = wsf(WS_DC) + (size_t)u * 16384;
        const int hh = lane >> 5, vv = lane & 31;
#pragma unroll
        for (int i = 0; i < 16; ++i) { const int k = 32 * kt + (i & 3) + 8 * (i >> 2) + 4 * hh;
            dc[k * 128 + 32 * vt0 + vv] = d0[i]; dc[k * 128 + 32 * vt0 + 32 + vv] = d1[i]; }
    }
    if (tid < 128) { float s_ = 0.f;
#pragma unroll
        for (int w = 0; w < 8; ++w) s_ += dnp[w * 128 + tid];
        wsf(WS_DN)[(size_t)u * 128 + tid] = s_; }
    __syncthreads();
}

__device__ __forceinline__ void phase_m2(Frame& F, int layer) {
    float* ca = (float*)F.lds; float* cb = ca + 32; float* cm = cb + 32;
    float* DNp = wsf(WS_DN); float* DCp = wsf(WS_DC); float* SCp = wsf(WS_SCAL); float* outp = KOUT; bf16_t* CBp = wsh(WS_CB);
    for (int u = F.bx; u < 12 * 33; u += F.G) {
        const int bh = u / 33, c = u % 33, b = bh / 6, h = bh % 6;
        __syncthreads();
        if (F.wave == 0) {
            const int ln = F.lane & 31;
            const float gmv = SCp[(size_t)(bh * 32 + ln) * 4 + 0], blv = SCp[(size_t)(bh * 32 + ln) * 4 + 1];
            float mm = 0.f, a_ = 0.f, b_ = 0.f, me = 0.f;
#pragma unroll
            for (int n = 0; n < 32; ++n) {
                const float g = rdlane_f(gmv, n), bl = rdlane_f(blv, n);
                const float mn = fmaxf(bl + mm, g);
                if (ln == n) { a_ = __expf(bl + mm - mn); b_ = __expf(g - mn); me = mm; }
                mm = mn;
            }
            if (F.lane < 32) { ca[ln] = a_; cb[ln] = b_; cm[ln] = me; if (c == 0) SCp[(size_t)(bh * 32 + ln) * 4 + 2] = me; }
            if (F.lane == 0) { cm[32] = mm; if (c == 0) outp[O_PM + (layer * 2 + b) * 6 + h] = mm; }
        }
        __syncthreads();
        if (c < 32) {
            const int e = c * 512 + F.tid;
            const float* base = DCp + (size_t)bh * 32 * 16384 + e;
            bf16_t* cbp = CBp + (size_t)bh * 32 * 16384 + e;
            float d[32];
#pragma unroll
            for (int n = 0; n < 32; ++n) d[n] = base[(size_t)n * 16384];
            float C = 0.f;
#pragma unroll
            for (int n = 0; n < 32; ++n) { cbp[(size_t)n * 16384] = (bf16_t)f2bf(C); C = ca[n] * C + cb[n] * d[n]; }
            outp[O_PC + ((size_t)((layer * 2 + b) * 6 + h)) * 16384 + e] = C;
        } else if (F.tid < 128) {
            float* base = DNp + (size_t)bh * 32 * 128 + F.tid;
            float d[32];
#pragma unroll
            for (int n = 0; n < 32; ++n) d[n] = base[n * 128];
            float C = 0.f;
            float* ne = wsf(WS_NE) + (size_t)bh * 32 * 128 + F.tid;
#pragma unroll
            for (int n = 0; n < 32; ++n) { ne[n * 128] = C; C = ca[n] * C + cb[n] * d[n]; }
            outp[O_PN + ((size_t)((layer * 2 + b) * 6 + h)) * 128 + F.tid] = C;
        }
    }
    __syncthreads();
}

__device__ __forceinline__ void m3_unit(Frame& F, int layer, int u) {
    const int n = u & 31, bh = u >> 5, h = bh % 6, b = bh / 6, tid = fresh_tid(F), lane = tid & 63, wave = __builtin_amdgcn_readfirstlane(tid >> 6);
    const int mbase = b * SEQ, m0 = mbase + n * 128;
    unsigned char* vimg = F.lds; unsigned char* cimg = F.lds + 40960;
    unsigned char* kimg = F.lds + 81920; unsigned char* qimg = F.lds + 81920 + 32768;
    float* hbuf = (float*)(F.lds + 81920);
    float* av = (float*)(F.lds + 149504); float* cv = av + 128; float* wi = cv + 128; float* emt = wi + 128; float* nst = emt + 128; float* dent = nst + 128;
    const bf16_t* P = wsh(WS_PROJ);
    const int tt = wave & 3, vh = wave >> 2, tl = lane & 31, hh = lane >> 5, t = 32 * tt + tl;
    u32x4 vreg[4], creg[4], kreg[4], qreg[4];
    {   const bf16_t* CBp = wsh(WS_CB) + (size_t)u * 16384;
        const bf16_t* QCb = wsh(WS_QC) + (size_t)m0 * 768 + h * 128; const bf16_t* KCb = wsh(WS_KC) + (size_t)m0 * 768 + h * 128;
#pragma unroll
        for (int i = 0; i < 4; ++i) { const int pid = i * 512 + tid, row = pid >> 4, ch = pid & 15;
            vreg[i] = *(const u32x4*)(P + (size_t)(m0 + row) * NPROJ + C_VC + h * 128 + ch * 8);
            creg[i] = *(const u32x4*)(CBp + row * 128 + ch * 8);
            kreg[i] = *(const u32x4*)(KCb + (size_t)row * 768 + ch * 8);
            qreg[i] = *(const u32x4*)(QCb + (size_t)row * 768 + ch * 8); } }
    const float m_n = wsf(WS_SCAL)[(size_t)u * 4 + 2];
    float ig0 = 0.f, ig1 = 0.f, lf0 = 0.f, lf1 = 0.f, nreg = 0.f;
    if (wave == 0) { const float* GT = wsf(WS_GATES) + (size_t)(m0 + 2 * lane) * 16; ig0 = GT[h]; lf0 = GT[6 + h]; ig1 = GT[16 + h]; lf1 = GT[16 + 6 + h]; }
    if (tid < 128) nreg = wsf(WS_NE)[(size_t)u * 128 + tid];
    __syncthreads();
#pragma unroll
    for (int i = 0; i < 4; ++i) { const int pid = i * 512 + tid, row = pid >> 4, ch = pid & 15;
        *(u32x4*)(vimg + row * IMG_LD + ch * 16) = vreg[i]; *(u32x4*)(cimg + row * IMG_LD + ch * 16) = creg[i];
        *(u32x4*)(kimg + row * 256 + ((ch ^ (row & 15)) << 4)) = kreg[i]; *(u32x4*)(qimg + row * 256 + ((ch ^ (row & 15)) << 4)) = qreg[i]; }
    if (tid < 128) nst[tid] = nreg;
    if (wave == 0) {
        const float sp = lf0 + lf1; float inc = sp;
#pragma unroll
        for (int o = 1; o < 64; o <<= 1) { const float x = __shfl_up(inc, o); if (lane >= o) inc += x; }
        const float c0 = inc - sp + lf0, c1 = inc;
        const float x0 = ig0 - c0, x1 = ig1 - c1, sx = fmaxf(x0, x1); float mxi = sx;
#pragma unroll
        for (int o = 1; o < 64; o <<= 1) { const float x = __shfl_up(mxi, o); if (lane >= o) mxi = fmaxf(mxi, x); }
        float exc = __shfl_up(mxi, 1); if (lane == 0) exc = -INFINITY;
        const float p0 = fmaxf(exc, x0), p1 = fmaxf(exc, sx);
        const float mt0 = c0 + fmaxf(m_n, p0), mt1 = c1 + fmaxf(m_n, p1);
        cv[2 * lane] = x0; cv[2 * lane + 1] = x1;
        av[2 * lane] = c0 - mt0; av[2 * lane + 1] = c1 - mt1;
        wi[2 * lane] = __expf(c0 + m_n - mt0); wi[2 * lane + 1] = __expf(c1 + m_n - mt1);
        emt[2 * lane] = __expf(-mt0); emt[2 * lane + 1] = __expf(-mt1);
    }
    __syncthreads();
    f32x16 H0, H1;
    {
        bf16x8 qf[8];
#pragma unroll
        for (int ks = 0; ks < 8; ++ks) qf[ks] = *(const bf16x8*)(qimg + t * 256 + (((2 * ks + hh) ^ (t & 15)) << 4));
#pragma unroll
        for (int i = 0; i < 16; ++i) { H0[i] = 0.f; H1[i] = 0.f; }
        float rowsum = 0.f;
        const float at = av[t];
#pragma unroll 1
        for (int st = 0; st <= tt; ++st) {
            f32x16 X;
#pragma unroll
            for (int i = 0; i < 16; ++i) X[i] = 0.f;
            const int krow = 32 * st + tl;
#pragma unroll
            for (int ks = 0; ks < 8; ++ks) { const bf16x8 kf = *(const bf16x8*)(kimg + krow * 256 + (((2 * ks + hh) ^ (krow & 15)) << 4)); X = __builtin_amdgcn_mfma_f32_32x32x16_bf16(kf, qf[ks], X, 0, 0, 0); }
#pragma unroll
            for (int i = 0; i < 16; ++i) { const int sl = (i & 3) + 8 * (i >> 2) + 4 * hh;
                const bool ok = (st < tt) || (sl <= tl);
                const float val = ok ? __expf(at + cv[32 * st + sl]) * X[i] : 0.f;
                rowsum += val; X[i] = val; }
#pragma unroll
            for (int s2 = 0; s2 < 2; ++s2) { const bf16x8 pa = pack_acc8(X, s2);
                const bf16x8 v0 = tr_frag_acc(vimg, IMG_LD, 32 * st + 16 * s2, 64 * vh, lane), v1 = tr_frag_acc(vimg, IMG_LD, 32 * st + 16 * s2, 64 * vh + 32, lane);
                H0 = __builtin_amdgcn_mfma_f32_32x32x16_bf16(pa, v0, H0, 0, 0, 0);
                H1 = __builtin_amdgcn_mfma_f32_32x32x16_bf16(pa, v1, H1, 0, 0, 0); }
        }
        rowsum += __shfl_xor(rowsum, 32);
        const float w = wi[t];
        float qn = 0.f;
#pragma unroll
        for (int ks = 0; ks < 8; ++ks) {
            u32x4 qw = __builtin_bit_cast(u32x4, qf[ks]);
            const float q0 = bf2f(qw.x & 0xffffu), q1 = bf2f(qw.x >> 16), q2 = bf2f(qw.y & 0xffffu), q3 = bf2f(qw.y >> 16), q4_ = bf2f(qw.z & 0xffffu), q5 = bf2f(qw.z >> 16), q6 = bf2f(qw.w & 0xffffu), q7 = bf2f(qw.w >> 16);
            const float* np = nst + 16 * ks + 8 * hh;
            qn += q0 * np[0] + q1 * np[1] + q2 * np[2] + q3 * np[3] + q4_ * np[4] + q5 * np[5] + q6 * np[6] + q7 * np[7];
            qw.x = pk2(q0 * w, q1 * w); qw.y = pk2(q2 * w, q3 * w); qw.z = pk2(q4_ * w, q5 * w); qw.w = pk2(q6 * w, q7 * w);
            qf[ks] = __builtin_bit_cast(bf16x8, qw);
        }
        qn += __shfl_xor(qn, 32);
        if (hh == 0) dent[vh * 128 + t] = fmaxf(fabsf(rowsum + w * qn), emt[t]);
#pragma unroll
        for (int ks = 0; ks < 8; ++ks) {
            const bf16x8 c0 = tr_frag_nat(cimg, IMG_LD, 16 * ks, 64 * vh, lane), c1 = tr_frag_nat(cimg, IMG_LD, 16 * ks, 64 * vh + 32, lane);
            H0 = __builtin_amdgcn_mfma_f32_32x32x16_bf16(qf[ks], c0, H0, 0, 0, 0);
            H1 = __builtin_amdgcn_mfma_f32_32x32x16_bf16(qf[ks], c1, H1, 0, 0, 0);
        }
    }
    const int tp = tid >> 2, part = tid & 3;
    const float* hg = KIN(I_HNG) + layer * 768 + h * 128 + part * 32;
    const bf16_t* po = P + (size_t)(m0 + tp) * NPROJ + C_OC + h * 128 + part * 32; const bf16_t* pz = P + (size_t)(m0 + tp) * NPROJ + C_ZC + h * 128 + part * 32;
    u32x4 owv[4], zwv[4]; f32x4 gv[8];
#pragma unroll
    for (int i = 0; i < 4; ++i) { owv[i] = *(const u32x4*)(po + 8 * i); zwv[i] = *(const u32x4*)(pz + 8 * i); gv[2 * i] = *(const f32x4*)(hg + 8 * i); gv[2 * i + 1] = *(const f32x4*)(hg + 8 * i + 4); }
    __syncthreads();
#pragma unroll
    for (int i = 0; i < 16; ++i) { const int tr_ = 32 * tt + (i & 3) + 8 * (i >> 2) + 4 * hh; const float dinv = 1.f / dent[vh * 128 + tr_];
        hbuf[tr_ * 132 + 64 * vh + tl] = H0[i] * dinv; hbuf[tr_ * 132 + 64 * vh + 32 + tl] = H1[i] * dinv; }
    __syncthreads();
    {
        f32x4 x[8]; float ss = 0.f;
#pragma unroll
        for (int i = 0; i < 8; ++i) { x[i] = *(const f32x4*)(hbuf + tp * 132 + part * 32 + 4 * i); ss += (x[i][0] * x[i][0] + x[i][1] * x[i][1]) + (x[i][2] * x[i][2] + x[i][3] * x[i][3]); }
        ss += __shfl_xor(ss, 1); ss += __shfl_xor(ss, 2);
        const float rs = rsqrtf(ss * (1.f / 128.f) + EPS);
        bf16_t* py = wsh(WS_YMIX) + (size_t)(m0 + tp) * D + 1280 + h * 128 + part * 32;
#pragma unroll
        for (int i = 0; i < 4; ++i) {
            const u32x4 ow = owv[i], zw = zwv[i];
            const f32x4 g0 = gv[2 * i], g1 = gv[2 * i + 1];
            const f32x4 a = x[2 * i], c = x[2 * i + 1];
            u32x4 y;
            y.x = pk2(a[0] * rs * g0[0] * sigmf(bf2f(ow.x & 0xffffu)) * siluf(bf2f(zw.x & 0xffffu)), a[1] * rs * g0[1] * sigmf(bf2f(ow.x >> 16)) * siluf(bf2f(zw.x >> 16)));
            y.y = pk2(a[2] * rs * g0[2] * sigmf(bf2f(ow.y & 0xffffu)) * siluf(bf2f(zw.y & 0xffffu)), a[3] * rs * g0[3] * sigmf(bf2f(ow.y >> 16)) * siluf(bf2f(zw.y >> 16)));
            y.z = pk2(c[0] * rs * g1[0] * sigmf(bf2f(ow.z & 0xffffu)) * siluf(bf2f(zw.z & 0xffffu)), c[1] * rs * g1[1] * sigmf(bf2f(ow.z >> 16)) * siluf(bf2f(zw.z >> 16)));
            y.w = pk2(c[2] * rs * g1[2] * sigmf(bf2f(ow.w & 0xffffu)) * siluf(bf2f(zw.w & 0xffffu)), c[3] * rs * g1[3] * sigmf(bf2f(ow.w >> 16)) * siluf(bf2f(zw.w >> 16)));
            *(u32x4*)(py + 8 * i) = y;
        }
    }
    __syncthreads();
}

__device__ __forceinline__ void ms_unit(Frame& F, int layer, int u) {
    const int h = u % 6, b = u / 6, tid = fresh_tid(F), lane = tid & 63, wave = __builtin_amdgcn_readfirstlane(tid >> 6), m0 = MP + b * 8;
    float* qs = (float*)F.lds; float* ks = qs + 1024; float* vs = ks + 1024; float* hb = vs + 1024;
    float* ig = hb + 1024; float* bhv = ig + 8; float* mt = bhv + 8; float* den = mt + 8; float* wsv = den + 8; float* Am = wsv + 8; float* misc = Am + 64; float* nq = misc + 8;
    float* cpart = nq + 8;
    const float* C0 = KIN(I_SC) + ((size_t)((layer * 8 + b) * 6 + h)) * 16384;
    const float* n0 = KIN(I_SN) + ((size_t)((layer * 8 + b) * 6 + h)) * 128;
    const float m0s = KIN(I_SM)[(layer * 8 + b) * 6 + h];
    const ConvP cp = conv_ptrs(layer); const float* GT = wsf(WS_GATES); float* outp = KOUT;
    const int v = tid & 127, kq = tid >> 7;
    float creg[32];
#pragma unroll
    for (int i = 0; i < 32; ++i) creg[i] = C0[(32 * kq + i) * 128 + v];
    __syncthreads();
    if (tid < 8) { ig[tid] = GT[(size_t)(m0 + tid) * 16 + h]; bhv[tid] = GT[(size_t)(m0 + tid) * 16 + 6 + h]; }
    for (int o = tid; o < 1024; o += 512) { const int t = o >> 7, c = o & 127;
        qs[o] = conv_qk<true>(cp, m0, b, t, h * 128 + c);
        ks[o] = conv_qk<true>(cp, m0, b, t, 768 + h * 128 + c) * 0.08838834764831845f;
        vs[o] = bf2f(cp.proj[(size_t)(m0 + t) * NPROJ + C_VC + h * 128 + c]); }
    __syncthreads();
    if (tid == 0) {
        float c = 0.f; for (int s = 0; s < 8; ++s) { c += bhv[s]; bhv[s] = c; }
        for (int t = 0; t < 8; ++t) { float mxx = bhv[t] + m0s; for (int s = 0; s <= t; ++s) mxx = fmaxf(mxx, bhv[t] - bhv[s] + ig[s]); mt[t] = mxx; }
        const float bl = bhv[7]; float mn = bl + m0s;
        for (int s = 0; s < 8; ++s) mn = fmaxf(mn, bl - bhv[s] + ig[s]);
        for (int s = 0; s < 8; ++s) wsv[s] = __expf(bl - bhv[s] + ig[s] - mn);
        misc[0] = mn; misc[1] = __expf(bl + m0s - mn);
        outp[O_SM + (layer * 8 + b) * 6 + h] = mn;
    }
    {
        const int d = tid >> 3, part = tid & 7, t = d >> 3, s_ = d & 7;
        float dot = 0.f, dn_ = 0.f;
#pragma unroll
        for (int k = 0; k < 16; ++k) { const float qv = qs[t * 128 + 16 * part + k]; dot += qv * ks[s_ * 128 + 16 * part + k]; if (s_ == 0) dn_ += qv * n0[16 * part + k]; }
        dot += __shfl_xor(dot, 1); dot += __shfl_xor(dot, 2); dot += __shfl_xor(dot, 4);
        dn_ += __shfl_xor(dn_, 1); dn_ += __shfl_xor(dn_, 2); dn_ += __shfl_xor(dn_, 4);
        __syncthreads();
        if (part == 0) { Am[d] = (s_ <= t) ? __expf(bhv[t] - bhv[s_] + ig[s_] - mt[t]) * dot : 0.f; if (s_ == 0) nq[t] = dn_; }
    }
    {
        float acc[8];
#pragma unroll
        for (int t = 0; t < 8; ++t) acc[t] = 0.f;
#pragma unroll
        for (int i = 0; i < 32; i += 4)
#pragma unroll
            for (int t = 0; t < 8; ++t) { const f32x4 q4 = *(const f32x4*)(qs + t * 128 + 32 * kq + i); acc[t] += (creg[i] * q4[0] + creg[i + 1] * q4[1]) + (creg[i + 2] * q4[2] + creg[i + 3] * q4[3]); }
#pragma unroll
        for (int t = 0; t < 8; ++t) cpart[(kq * 8 + t) * 128 + v] = acc[t];
    }
    __syncthreads();
    if (tid < 8) { const int t = tid; float d = 0.f;
        for (int s = 0; s < 8; ++s) d += Am[t * 8 + s];
        d += __expf(bhv[t] + m0s - mt[t]) * nq[t];
        den[t] = fmaxf(fabsf(d), __expf(-mt[t])); }
    __syncthreads();
    {
        const int t = wave; float hv[2], ss = 0.f;
#pragma unroll
        for (int j = 0; j < 2; ++j) { const int vv = lane + 64 * j; float a = 0.f;
            for (int s = 0; s < 8; ++s) a += Am[t * 8 + s] * vs[s * 128 + vv];
            const float c2 = (cpart[(0 * 8 + t) * 128 + vv] + cpart[(1 * 8 + t) * 128 + vv]) + (cpart[(2 * 8 + t) * 128 + vv] + cpart[(3 * 8 + t) * 128 + vv]);
            hv[j] = (a + __expf(bhv[t] + m0s - mt[t]) * c2) / den[t]; ss += hv[j] * hv[j]; }
        ss = wave_sum(ss);
        const float rs = rsqrtf(ss * (1.f / 128.f) + EPS);
        const float* hg = KIN(I_HNG) + layer * 768 + h * 128; bf16_t* Y = wsh(WS_YMIX);
#pragma unroll
        for (int j = 0; j < 2; ++j) { const int vv = lane + 64 * j; const size_t pr = (size_t)(m0 + t) * NPROJ;
            const float og = bf2f(cp.proj[pr + C_OC + h * 128 + vv]), z = bf2f(cp.proj[pr + C_ZC + h * 128 + vv]);
            Y[(size_t)(m0 + t) * D + 1280 + h * 128 + vv] = (bf16_t)f2bf(hv[j] * rs * hg[vv] * sigmf(og) * siluf(z)); }
    }
    {   const float wc = misc[1];
        float wv[8];
#pragma unroll
        for (int s = 0; s < 8; ++s) wv[s] = wsv[s] * vs[s * 128 + v];
        float* Co = outp + O_SC + ((size_t)((layer * 8 + b) * 6 + h)) * 16384;
#pragma unroll
        for (int i = 0; i < 32; ++i) { const int k = 32 * kq + i; float a = wc * creg[i];
#pragma unroll
            for (int s = 0; s < 8; ++s) a += ks[s * 128 + k] * wv[s];
            Co[k * 128 + v] = a; }
        if (tid < 128) { float a = wc * n0[tid]; for (int s = 0; s < 8; ++s) a += wsv[s] * ks[s * 128 + tid]; outp[O_SN + ((size_t)((layer * 8 + b) * 6 + h)) * 128 + tid] = a; }
    }
    __syncthreads();
}

template <int MODE  >
__device__ __forceinline__ void skinny_unit(Frame& F, int layer, int unit) {
    const int tid = fresh_tid(F), lane = tid & 63, wave = __builtin_amdgcn_readfirstlane(tid >> 6), hh = lane >> 5, l31 = lane & 31;
    const int n0 = unit * 64;
    const bf16_t* A = (MODE == 0 ? wsh(WS_A) : wsh(WS_YMIX)) + (size_t)MP * D;
    const bf16_t* Bt = (MODE == 0 ? wsh(WS_WIN) + (size_t)layer * NIN * D : wsh(WS_WOUT) + (size_t)layer * D * D) + (size_t)n0 * D;
    float* part = (float*)F.lds;
    f32x16 acc[2][2];
#pragma unroll
    for (int a = 0; a < 2; ++a)
#pragma unroll
        for (int b = 0; b < 2; ++b)
#pragma unroll
            for (int i = 0; i < 16; ++i) acc[a][b][i] = 0.f;
    unsigned char* stg = F.lds + wave * 16384;
    const int lr = lane >> 3, lp = lane & 7;
    const bf16_t* asrc = A + (size_t)lr * D + wave * 256 + lp * 8; const bf16_t* bsrc = Bt + (size_t)lr * D + wave * 256 + lp * 8;
    u32x4 sreg[16];
#pragma unroll
    for (int i = 0; i < 8; ++i) { sreg[i] = *(const u32x4*)(asrc + (size_t)(8 * i) * D); sreg[8 + i] = *(const u32x4*)(bsrc + (size_t)(8 * i) * D); }
    __syncthreads();
#pragma unroll 1
    for (int kb = 0; kb < 4; ++kb) {
#pragma unroll
        for (int i = 0; i < 16; ++i) { const int r = 8 * i + lr; *(u32x4*)(stg + r * 128 + ((lp ^ ((r >> 1) & 7)) << 4)) = sreg[i]; }
        if (kb < 3) {
#pragma unroll
            for (int i = 0; i < 8; ++i) { sreg[i] = *(const u32x4*)(asrc + (size_t)(8 * i) * D + 64 * (kb + 1)); sreg[8 + i] = *(const u32x4*)(bsrc + (size_t)(8 * i) * D + 64 * (kb + 1)); }
        }
#pragma unroll
        for (int k4 = 0; k4 < 4; ++k4) {
            bf16x8 a[2], b[2];
#pragma unroll
            for (int rt = 0; rt < 2; ++rt) { const int ra = 32 * rt + l31, rb = 64 + 32 * rt + l31;
                a[rt] = *(const bf16x8*)(stg + ra * 128 + (((2 * k4 + hh) ^ ((ra >> 1) & 7)) << 4));
                b[rt] = *(const bf16x8*)(stg + rb * 128 + (((2 * k4 + hh) ^ ((rb >> 1) & 7)) << 4)); }
#pragma unroll
            for (int rt = 0; rt < 2; ++rt)
#pragma unroll
                for (int ct = 0; ct < 2; ++ct) acc[rt][ct] = __builtin_amdgcn_mfma_f32_32x32x16_bf16(a[rt], b[ct], acc[rt][ct], 0, 0, 0);
        }
        asm volatile("s_waitcnt lgkmcnt(0)" ::: "memory");
    }
    __syncthreads();
#pragma unroll
    for (int rt = 0; rt < 2; ++rt)
#pragma unroll
        for (int ct = 0; ct < 2; ++ct)
#pragma unroll
            for (int i = 0; i < 16; ++i) part[(wave * 64 + 32 * rt + (i & 3) + 8 * (i >> 2) + 4 * hh) * 68 + 32 * ct + l31] = acc[rt][ct][i];
    __syncthreads();
    const int row = tid >> 3, c8 = (tid & 7) * 8, m = MP + row, jb = 2 + (row >> 3), col = n0 + c8;
    float v[8];
#pragma unroll
    for (int i = 0; i < 8; ++i) v[i] = 0.f;
#pragma unroll
    for (int w = 0; w < 8; ++w) { const f32x4 p0 = *(const f32x4*)(part + (w * 64 + row) * 68 + c8), p1 = *(const f32x4*)(part + (w * 64 + row) * 68 + c8 + 4);
        v[0] += p0[0]; v[1] += p0[1]; v[2] += p0[2]; v[3] += p0[3]; v[4] += p1[0]; v[5] += p1[1]; v[6] += p1[2]; v[7] += p1[3]; }
    if (MODE == 0) {
        const float rstd = rsqrtf(wsf(WS_SSQ)[(size_t)layer * MPAD + m] * (1.f / 2048.f) + EPS);
        const float* bp_ = wsf(WS_BIAS) + ((size_t)layer * 10 + jb) * NIN + col;
        { const f32x4 b0 = *(const f32x4*)bp_, b1 = *(const f32x4*)(bp_ + 4);
          v[0] = v[0] * rstd + b0[0]; v[1] = v[1] * rstd + b0[1]; v[2] = v[2] * rstd + b0[2]; v[3] = v[3] * rstd + b0[3];
          v[4] = v[4] * rstd + b1[0]; v[5] = v[5] * rstd + b1[1]; v[6] = v[6] * rstd + b1[2]; v[7] = v[7] * rstd + b1[3]; }
        float* out = KOUT;
        if (n0 < C_VA) {
            float ss = 0.f;
#pragma unroll
            for (int i = 0; i < 8; ++i) ss += v[i] * v[i];
            ss += __shfl_xor(ss, 1); ss += __shfl_xor(ss, 2); ss += __shfl_xor(ss, 4);
            const float r = rsqrtf(ss * (1.f / 64.f) + EPS) * (n0 < C_KA ? 0.125f * 1.4426950408889634f : 1.f);
            const float* gp = (n0 < C_KA ? KIN(I_QNG) : KIN(I_KNG)) + layer * 64 + c8;
#pragma unroll
            for (int i = 0; i < 8; ++i) v[i] *= r * gp[i];
        }
        float* dst = nullptr;
        if (n0 >= C_KA && n0 < C_ZA) dst = out + (n0 < C_VA ? O_SK : O_SV) + (size_t)(layer * 64 + row) * 768 + (col - (n0 < C_VA ? C_KA : C_VA));
        if (n0 >= C_QKC && n0 < C_VC && (row & 7) >= 5) dst = out + O_SCONV + (size_t)((layer * 8 + (row >> 3)) * 3 + ((row & 7) - 5)) * 1536 + (col - C_QKC);
        if (dst) { *(f32x4*)dst = (f32x4){v[0], v[1], v[2], v[3]}; *(f32x4*)(dst + 4) = (f32x4){v[4], v[5], v[6], v[7]}; }
        if (n0 < NPROJ) { u32x4 w; w.x = pk2(v[0], v[1]); w.y = pk2(v[2], v[3]); w.z = pk2(v[4], v[5]); w.w = pk2(v[6], v[7]); *(u32x4*)(wsh(WS_PROJ) + (size_t)m * NPROJ + col) = w; }
        else if (c8 < 16) { const float* ibias = KIN(I_IB) + layer * 6; const float* fbias = KIN(I_FB) + layer * 6; float* gates = wsf(WS_GATES);
#pragma unroll
            for (int i = 0; i < 8; ++i) { const int gi = c8 + i; if (gi < 12) { float val = v[i]; if (gi < 6) val += ibias[gi]; else val = logsigf(val + fbias[gi - 6]); gates[(size_t)m * 16 + gi] = val; } } }
    } else {
        const float* xin = layer == 0 ? KIN(I_XS) + (size_t)row * D : KOUT + (size_t)m * D;
        const float* gp = wsf(WS_MOD) + ((size_t)layer * 10 + jb) * 6144 + 4096 + col;
        const f32x4 x0 = *(const f32x4*)(xin + col), x1 = *(const f32x4*)(xin + col + 4), g0 = *(const f32x4*)gp, g1 = *(const f32x4*)(gp + 4);
        const f32x4 y0 = x0 + g0 * (f32x4){v[0], v[1], v[2], v[3]}, y1 = x1 + g1 * (f32x4){v[4], v[5], v[6], v[7]};
        float* op = KOUT + (size_t)m * D + col; *(f32x4*)op = y0; *(f32x4*)(op + 4) = y1;
        if (layer + 1 < DEPTH) {
            const float* ge = wsf(WS_GEFF) + ((size_t)(layer + 1) * 10 + jb) * D + col;
            const f32x4 a0 = y0 * *(const f32x4*)ge, a1 = y1 * *(const f32x4*)(ge + 4);
            u32x4 w; w.x = pk2(a0[0], a0[1]); w.y = pk2(a0[2], a0[3]); w.z = pk2(a1[0], a1[1]); w.w = pk2(a1[2], a1[3]);
            *(u32x4*)(wsh(WS_A) + (size_t)m * D + col) = w;
            float ss = (y0[0] * y0[0] + y0[1] * y0[1]) + (y0[2] * y0[2] + y0[3] * y0[3]) + (y1[0] * y1[0] + y1[1] * y1[1]) + (y1[2] * y1[2] + y1[3] * y1[3]);
            ss += __shfl_xor(ss, 1); ss += __shfl_xor(ss, 2); ss += __shfl_xor(ss, 4);
            if ((tid & 7) == 0) atomicAdd(wsf(WS_SSQ) + (size_t)(layer + 1) * MPAD + m, ss);
        }
    }
}

constexpr int CW_CNT = 16384;
__device__ __forceinline__ void unit_publish(unsigned* cnt) {
    asm volatile("s_waitcnt vmcnt(0)" ::: "memory");
    __syncthreads();
    if (threadIdx.x == 0) {
        __builtin_amdgcn_fence(__ATOMIC_RELEASE, "agent");
        asm volatile("s_waitcnt vmcnt(0)" ::: "memory");
        __hip_atomic_fetch_add(cnt, 1u, __ATOMIC_RELAXED, __HIP_MEMORY_SCOPE_AGENT);
    }
}
__device__ __forceinline__ void unit_wait(unsigned* cnt, unsigned need) {
    if (threadIdx.x == 0) {
        unsigned sp = 0u;
        while (__hip_atomic_load(cnt, __ATOMIC_RELAXED, __HIP_MEMORY_SCOPE_AGENT) < need) { __builtin_amdgcn_s_sleep(2); if (++sp > (1u << 24)) break; }
        __builtin_amdgcn_fence(__ATOMIC_ACQUIRE, "agent");
        asm volatile("s_waitcnt vmcnt(0)" ::: "memory");
    }
    __syncthreads();
}
__device__ __forceinline__ void phase_ma(Frame& F, int layer, int kinds, bool dynamic) {
    constexpr int U_SKO = 32, U_M1 = 384, U_SGU = 256, U_AT = ATT_JOBS, U_SK = 133, U_TOT = U_SKO + U_M1 + U_SGU + U_AT + U_SK;
    unsigned* ctr = (unsigned*)(KA()->ws + WS_CTL) + CW_Q + 64 * layer;
    unsigned* cnt_sko = (unsigned*)(KA()->ws + WS_CTL) + CW_CNT + 64 * layer;
    volatile unsigned* slot = (volatile unsigned*)(F.lds + LDSCTL_OFF + 64);
    unsigned pre = 0u;
    if (dynamic) { if (F.tid == 0) pre = __hip_atomic_fetch_add(ctr, 1u, __ATOMIC_RELAXED, __HIP_MEMORY_SCOPE_AGENT); }
    else pre = (unsigned)F.bx;
    for (;;) {
        unsigned u;
        if (dynamic) {
            __syncthreads();
            if (F.tid == 0) slot[0] = pre;
            __syncthreads();
            u = slot[0];
            if (u >= (unsigned)U_TOT) break;
            if (F.tid == 0) pre = __hip_atomic_fetch_add(ctr, 1u, __ATOMIC_RELAXED, __HIP_MEMORY_SCOPE_AGENT);
        } else { u = pre; if (u >= (unsigned)U_TOT) break; pre += (unsigned)F.G; }
        int r = (int)u;
        if (r < U_SKO) { if (dynamic && layer > 0 && F.G != 256) { skinny_unit<1>(F, layer - 1, r); unit_publish(cnt_sko); } continue; } r -= U_SKO;
        if (r < U_M1) { if (kinds & 2) m1_unit(F, layer, r); continue; } r -= U_M1;
        if (r < U_SK) { if (kinds & 8) { if (dynamic && layer > 0 && F.G != 256) unit_wait(cnt_sko, (unsigned)U_SKO); skinny_unit<0>(F, layer, r); } continue; } r -= U_SK;
        if (r < U_SGU) { const int g = r & 3, ch = (r >> 2) & 31, b = r >> 7; if (kinds & 4) sgu_unit_mfma(F, layer, b * SEQ + ch * 128, g); continue; } r -= U_SGU;
        if (kinds & 1) attn_job(F, layer, r);
    }
    __syncthreads();
}
__device__ __forceinline__ void phase_mixs(Frame& F, int layer) {
    constexpr int U_SA = 96, U_MS = 48, U_SGUS = 32, U_TOT = U_SA + U_MS + U_SGUS;
    for (int u = F.G - 1 - F.bx; u < U_TOT; u += F.G) {
        int r = u;
        if (r < U_SA) { __syncthreads(); sattn_item(F, layer, r * 8 + F.wave); __syncthreads(); continue; } r -= U_SA;
        if (r < U_MS) { ms_unit(F, layer, r); continue; } r -= U_MS;
        { const int g = r & 3, b = r >> 2; sgu_unit(F, layer, MP + b * 8, 8, g, KOUT + O_SGU + (size_t)(layer * 64 + b * 8) * 512); }
    }
}

__device__ __forceinline__ void phase_m3(Frame& F, int layer, bool dynamic, int kinds) {
    constexpr int U_MIXS = 176, U_M3 = 384, U_CB = 256, U_TOT = U_MIXS + U_M3 + U_CB;
    unsigned* ctr = (unsigned*)(KA()->ws + WS_CTL) + CW_Q + 64 * (DEPTH + layer);
    volatile unsigned* slot = (volatile unsigned*)(F.lds + LDSCTL_OFF + 64);
    unsigned pre = 0u;
    if (dynamic) { if (F.tid == 0) pre = __hip_atomic_fetch_add(ctr, 1u, __ATOMIC_RELAXED, __HIP_MEMORY_SCOPE_AGENT); }
    else pre = (unsigned)F.bx;
    for (;;) {
        unsigned u;
        if (dynamic) {
            __syncthreads();
            if (F.tid == 0) slot[0] = pre;
            __syncthreads();
            u = slot[0];
            if (u >= (unsigned)U_TOT) break;
            if (F.tid == 0) pre = __hip_atomic_fetch_add(ctr, 1u, __ATOMIC_RELAXED, __HIP_MEMORY_SCOPE_AGENT);
        } else { u = pre; if (u >= (unsigned)U_TOT) break; pre += (unsigned)F.G; }
        int r = (int)u;
        if (r < U_MIXS) {
            if (!(kinds & 1)) continue;
            if (r < 96) { if (kinds & 8) { __syncthreads(); sattn_item(F, layer, r * 8 + F.wave); } }
            else if (r < 144) { if (kinds & 16) ms_unit(F, layer, r - 96); }
            else if (kinds & 32) { const int q_ = r - 144, g = q_ & 3, b = q_ >> 2; sgu_unit(F, layer, MP + b * 8, 8, g, KOUT + O_SGU + (size_t)(layer * 64 + b * 8) * 512); }
            continue; } r -= U_MIXS;
        if (r < U_M3) { if (kinds & 2) m3_unit(F, layer, r); continue; } r -= U_M3;
        if (!(kinds & 4)) continue;
#pragma unroll
        for (int i = 0; i < 4; ++i) attn_combine_row(F, r * 32 + F.wave * 4 + i);
    }
    __syncthreads();
}

constexpr int N_PHASES = 2 + 5 * DEPTH;
__global__ void __launch_bounds__(512, 2) fwd_kernel(Args args) {
    extern __shared__ __attribute__((aligned(16))) unsigned char lds[];
    LAS unsigned char* ldsl = (LAS unsigned char*)lds;
    for (int u = threadIdx.x; u < (LDS_BYTES - LDSCTL_OFF) / 4; u += 512) ((LAS unsigned*)(ldsl + LDSCTL_OFF))[u] = 0u;
    __syncthreads();
    unsigned* ctl = (unsigned*)(KA()->ws + WS_CTL);
    XcdBarrier bar; bar.bar = ctl + CW_BAR; bar.x = 0; bar.st = nullptr;
    const int lo = args.ph_lo, hi = args.ph_hi;
    if (hi - lo > 1) bar = xcd_barrier_post(ctl + CW_BAR, (volatile LAS unsigned*)(ldsl + LDSCTL_OFF + 32));

#ifndef DUP_MASK
#define DUP_MASK 0
#endif
    for (int ph2 = 2 * lo; ph2 < 2 * hi; ++ph2) {
        const int ph = ph2 >> 1;
        if (ph2 & 1) {
            const int kk_ = ph < 2 ? ph : 2 + (ph - 2) % 5;
            if (!((DUP_MASK >> kk_) & 1)) { if (DUP_MASK & 128) xcd_barrier(bar); continue; }
        }
        Frame F; F.lds = lds;
        { int t_ = threadIdx.x; asm volatile("" : "+v"(t_)); F.tid = t_; F.lane = t_ & 63; F.wave = __builtin_amdgcn_readfirstlane(t_ >> 6); }
        int bx_ = blockIdx.x; asm volatile("" : "+s"(bx_));
        F.G = gridDim.x; F.vcu = (F.G % 8 == 0) ? (bx_ % 8) * (F.G / 8) + bx_ / 8 : bx_; F.bx = bx_;
#ifndef DBG_MASK
#define DBG_MASK 0xff
#endif
        if (ph == 0) { if (DBG_MASK & 1) phase_p0(F); }
        else if (ph == 1) { if (DBG_MASK & 2) phase_p1(F, !(ph2 & 1)); }
        else {
            const int l = (ph - 2) / 5, k = (ph - 2) % 5;
            if (k == 0) { if (DBG_MASK & 4) {
                pg8::Gemm g{wsh(WS_A), wsh(WS_WIN) + (size_t)l * NIN * D, MP, NIN, D}; pg8::OrderIn S; S.init(MP, NIN, F.G, F.bx); S.i0 = 0; S.i1 = (F.G == 256) ? 4 : (1 << 20);
#ifndef PROBE_NOSTORE
#define PROBE_NOSTORE 0
#endif
                pg8::EpiIn E{l, (PROBE_NOSTORE && (ph2 & 1)) ? 1 : 0};
                if ((F.G == 256) && !(ph2 & 1) && l < DEPTH - 1 && (F.bx & 1)) { bias_unit(F, l + 1, F.bx >> 1); __syncthreads(); }
                pg8::gemm_phase<pg8::EpiIn, pg8::OrderIn>(ldsl, g, S, E, F.tid);
                if ((F.G == 256) && !(ph2 & 1) && l > 0 && !(F.bx & 1) && (F.bx >> 1) < 32) skinny_unit<1>(F, l - 1, F.bx >> 1); }
            } else if (k == 1) {
#ifndef DUP_SUB
#define DUP_SUB 31
#endif
                if (DBG_MASK & 8) {
                    if (!(ph2 & 1) && F.G == 256) {
                        pg8::Gemm g{wsh(WS_A), wsh(WS_WIN) + (size_t)l * NIN * D, MP, NIN, D}; pg8::OrderIn S; S.init(MP, NIN, F.G, F.bx); S.i0 = 4; S.i1 = 5;
                        pg8::EpiIn E{l, 0};
                        pg8::gemm_phase<pg8::EpiIn, pg8::OrderIn>(ldsl, g, S, E, F.tid);
                    }
                    phase_ma(F, l, (ph2 & 1) ? DUP_SUB : 31, !(ph2 & 1));
                }
            } else if (k == 2) {
                if (DBG_MASK & 16) phase_m2(F, l);
            } else if (k == 3) {
                if (DBG_MASK & 32) phase_m3(F, l, !(ph2 & 1), (ph2 & 1) ? DUP_SUB : 63);
            } else if (DBG_MASK & 64) {
                pg8::Gemm g{wsh(WS_YMIX), wsh(WS_WOUT) + (size_t)l * D * D, MP, D, D}; pg8::StaticOrder S; S.init(MP, D, F.G, F.bx);
                pg8::EpiOut E{l, (ph2 & 1) ? 0 : ((DUP_MASK >> 6) & 1)};
                pg8::gemm_phase<pg8::EpiOut, pg8::StaticOrder>(ldsl, g, S, E, F.tid);
                if (l == DEPTH - 1 && !E.nostore) { for (int u = F.bx; u < 32; u += F.G) skinny_unit<1>(F, l, u); }
            }
        }
        if (ph2 + 1 < 2 * hi) xcd_barrier(bar);
    }
}

extern "C" void kernel_launch(void* const* d_in, const int* in_sizes, int n_in, void* d_out, int out_size, void* d_ws, size_t ws_size, hipStream_t stream) {
    static int grid = 0;
    if (grid == 0) {
        if (n_in != 26 || (size_t)out_size != O_END || ws_size < WS_END) { fprintf(stderr, "kernel_launch: unexpected shapes: n_in %d out %d ws %zu\n", n_in, out_size, ws_size); grid = -1; return; }
        int dev = 0, cus = 0, per_cu = 0;
        if (hipGetDevice(&dev) != hipSuccess || hipDeviceGetAttribute(&cus, hipDeviceAttributeMultiprocessorCount, dev) != hipSuccess) { grid = -1; return; }
        if (hipFuncSetAttribute((const void*)fwd_kernel, hipFuncAttributeMaxDynamicSharedMemorySize, LDS_BYTES) != hipSuccess) { fprintf(stderr, "kernel_launch: hipFuncSetAttribute failed\n"); grid = -1; return; }
        if (hipOccupancyMaxActiveBlocksPerMultiprocessor(&per_cu, (const void*)fwd_kernel, 512, LDS_BYTES) != hipSuccess || per_cu < 1) { fprintf(stderr, "kernel_launch: occupancy query says %d blocks/CU\n", per_cu); }
        (void)hipGetLastError();
        grid = cus;
    }
    if (grid < 0) return;
    if (hipMemsetAsync((char*)d_ws + WS_CTL, 0, CTL_ZERO_BYTES, stream) != hipSuccess) return;
    Args a{};
    for (int i = 0; i < 26; ++i) a.in[i] = (const float*)d_in[i];
    a.out = (float*)d_out; a.ws = (unsigned char*)d_ws;
#if MK_N_LAUNCHES == 1
    a.ph_lo = 0; a.ph_hi = N_PHASES;
    hipLaunchKernelGGL(fwd_kernel, dim3(grid), dim3(512), LDS_BYTES, stream, a);
#else
    for (int p = 0; p < N_PHASES; ++p) { a.ph_lo = p; a.ph_hi = p + 1; hipLaunchKernelGGL(fwd_kernel, dim3(grid), dim3(512), LDS_BYTES, stream, a); }
#endif
}
```

```cpp
#include <hip/hip_runtime.h>
#include <cstdio>
#include <cstdint>

#ifndef MK_N_LAUNCHES
#define MK_N_LAUNCHES 1
#endif

constexpr int D = 2048, SEQ = 4096, MP = 8192, MS = 64, MV = 8256, MPAD = 8448;
constexpr int DIN = 8460, NPROJ = 8448, NIN = 8704, DEPTH = 4;
constexpr int C_KA = 768, C_VA = 1536, C_ZA = 2304, C_UB = 3072, C_VB = 3584, C_ZB = 4096, C_QKC = 4608, C_VC = 6144, C_OC = 6912, C_ZC = 7680;
constexpr float EPS = 1e-6f;
constexpr size_t O_YP = 0, O_YS = 16777216, O_PK = O_YS + 131072, O_PV = O_PK + 12582912, O_PCONV = O_PV + 12582912, O_PC = O_PCONV + 36864,
                 O_PN = O_PC + 786432, O_PM = O_PN + 6144, O_SK = O_PM + 48, O_SV = O_SK + 196608, O_SGU = O_SV + 196608, O_SCONV = O_SGU + 131072,
                 O_SC = O_SCONV + 147456, O_SN = O_SC + 3145728, O_SM = O_SN + 24576, O_END = O_SM + 192;
constexpr size_t MiB = 1u << 20;
constexpr size_t WS_CTL = 0, CTL_ZERO_BYTES = 1 * MiB;
constexpr size_t WS_MOD = 1 * MiB;
constexpr size_t WS_BIAS = 2 * MiB;
constexpr size_t WS_GEFF = 4 * MiB;
constexpr size_t WS_SSQ = 5 * MiB;
constexpr size_t WS_GATES = 6 * MiB;
constexpr size_t WS_SCAL = 7 * MiB;
constexpr size_t WS_WIN = 8 * MiB;
constexpr size_t WS_WOUT = 144 * MiB;
constexpr size_t WS_A = 176 * MiB;
constexpr size_t WS_YMIX = 210 * MiB;
constexpr size_t WS_PROJ = 244 * MiB;
constexpr size_t WS_DC = 381 * MiB;
constexpr size_t WS_OA = 405 * MiB;
constexpr size_t WS_LA = 441 * MiB;
constexpr size_t WS_BT = 443 * MiB;
constexpr size_t WS_QC = 444 * MiB;
constexpr size_t WS_KC = 456 * MiB;
constexpr size_t WS_CB = 468 * MiB;
constexpr size_t WS_XB = 480 * MiB;
constexpr size_t WS_SGW = 512 * MiB;
constexpr size_t WS_END = 513 * MiB;
constexpr int CW_BAR = 4096;
constexpr int CW_Q = 8192;

constexpr int SCR_BYTES = 155648;
constexpr int LDSCTL_OFF = SCR_BYTES, LDS_BYTES = SCR_BYTES + 1024;

__constant__ unsigned char c_bucket[3][132] = {
{0,1,2,3,4,5,6,7,8,9,10,11,12,13,14,15,16,16,16,16,16,16,17,17,17,17,17,17,17,17,18,18,18,18,18,18,18,18,18,18,19,19,19,19,19,19,19,19,19,19,19,19,19,19,20,20,20,20,20,20,20,20,20,20,20,20,20,20,20,20,20,20,20,21,21,21,21,21,21,21,21,21,21,21,21,21,21,21,21,21,21,21,21,21,21,21,21,21,21,22,22,22,22,22,22,22,22,22,22,22,22,22,22,22,22,22,22,22,22,22,22,22,22,22,22,22,22,22,22,0,0,0},
{0,4,8,12,16,16,17,17,18,18,19,19,19,19,20,20,20,20,20,21,21,21,21,21,21,22,22,22,22,22,22,22,22,22,23,23,23,23,23,23,23,23,23,23,23,23,24,24,24,24,24,24,24,24,24,24,24,24,24,24,24,24,25,25,25,25,25,25,25,25,25,25,25,25,25,25,25,25,25,25,25,25,25,26,26,26,26,26,26,26,26,26,26,26,26,26,26,26,26,26,26,26,26,26,26,26,26,26,26,26,26,26,26,27,27,27,27,27,27,27,27,27,27,27,27,27,27,27,27,0,0,0},
{0,16,18,19,20,21,21,22,22,23,23,23,24,24,24,24,25,25,25,25,25,26,26,26,26,26,26,26,26,27,27,27,27,27,27,27,27,27,27,28,28,28,28,28,28,28,28,28,28,28,28,28,29,29,29,29,29,29,29,29,29,29,29,29,29,29,29,29,29,29,30,30,30,30,30,30,30,30,30,30,30,30,30,30,30,30,30,30,30,30,30,30,30,30,30,31,31,31,31,31,31,31,31,31,31,31,31,31,31,31,31,31,31,31,31,31,31,31,31,31,31,31,31,31,31,31,31,31,31,0,0,0}};

#define GAS __attribute__((address_space(1)))
#define LAS __attribute__((address_space(3)))
typedef unsigned short bf16_t;
typedef short bf16x8 __attribute__((ext_vector_type(8)));
typedef float f32x4 __attribute__((ext_vector_type(4)));
typedef unsigned u32x4 __attribute__((ext_vector_type(4)));
typedef unsigned u32x2 __attribute__((ext_vector_type(2)));
typedef float f32x16 __attribute__((ext_vector_type(16)));
typedef short v4i16_t __attribute__((ext_vector_type(4)));

__device__ __forceinline__ float bf2f(unsigned u) { return __uint_as_float(u << 16); }
typedef float f32x2_t __attribute__((ext_vector_type(2))); typedef __bf16 bf16x2_t __attribute__((ext_vector_type(2)));
__device__ __forceinline__ unsigned pk2(float lo, float hi) { const f32x2_t v = {lo, hi}; const bf16x2_t b = __builtin_convertvector(v, bf16x2_t); return __builtin_bit_cast(unsigned, b); }
__device__ __forceinline__ unsigned f2bf(float f) { return pk2(f, 0.f) & 0xffffu; }
__device__ __forceinline__ void st_wt16(void* p, u32x4 v) {
    unsigned long long* q = (unsigned long long*)p;
    __hip_atomic_store(q, (unsigned long long)v.x | ((unsigned long long)v.y << 32), __ATOMIC_RELAXED, __HIP_MEMORY_SCOPE_AGENT);
    __hip_atomic_store(q + 1, (unsigned long long)v.z | ((unsigned long long)v.w << 32), __ATOMIC_RELAXED, __HIP_MEMORY_SCOPE_AGENT);
}
__device__ __forceinline__ float siluf(float x) { return x / (1.f + __expf(-x)); }
__device__ __forceinline__ float sigmf(float x) { return 1.f / (1.f + __expf(-x)); }
__device__ __forceinline__ float logsigf(float x) { return fminf(x, 0.f) - log1pf(__expf(-fabsf(x))); }
__device__ __forceinline__ float wave_sum(float v) {
#pragma unroll
    for (int o = 1; o < 64; o <<= 1) v += __shfl_xor(v, o);
    return v;
}
__device__ __forceinline__ float wave_max(float v) {
#pragma unroll
    for (int o = 1; o < 64; o <<= 1) v = fmaxf(v, __shfl_xor(v, o));
    return v;
}
__device__ __forceinline__ float rdlane_f(float v, int l) { return __int_as_float(__builtin_amdgcn_readlane(__float_as_int(v), l)); }

struct Args { const float* in[26]; float* out; unsigned char* ws; int ph_lo, ph_hi; };
struct Frame;
struct Frame {
    unsigned char* lds;
    int tid, lane, wave, vcu, G, bx;
};
__device__ __forceinline__ int fresh_tid(const Frame& F) { int t = F.tid; asm volatile("" : "+v"(t)); return t; }
typedef const __attribute__((address_space(4))) Args* kargs_t;
__device__ __forceinline__ kargs_t KA() { kargs_t p = (kargs_t)__builtin_amdgcn_kernarg_segment_ptr(); asm volatile("" : "+s"(p)); return p; }
#define KIN(i) (KA()->in[i])
#define KOUT (KA()->out)
__device__ __forceinline__ float* wsf(size_t off) { return (float*)(KA()->ws + off); }
__device__ __forceinline__ bf16_t* wsh(size_t off) { return (bf16_t*)(KA()->ws + off); }
constexpr size_t WS_DN = WS_SCAL + 2 * 6 * 32 * 4 * 4;
constexpr size_t WS_NE = WS_DN + 12 * 32 * 128 * 4;
enum { I_XP = 0, I_XS, I_CP, I_CS, I_CK, I_CV, I_SCONV, I_SC, I_SN, I_SM, I_RELB, I_NORMG, I_ADAW, I_ADAB, I_WIN, I_QNG, I_KNG, I_SGUG, I_SGUW, I_SGUB, I_CONVW, I_CONVB, I_FB, I_IB, I_HNG, I_WOUT };

namespace pg8 {
constexpr int BM = 256, BK = 64, HALF = 128, HTB = HALF * BK * 2, STAGE_BYTES = 8 * HTB, NXCD = 8, WGM = 8;
__host__ __device__ __forceinline__ int lds_byte(int r, int c) { const int st = (r >> 4) * 2 + (c >> 5), rr = r & 15, cc = c & 31, ob = rr * 64 + cc * 2; return st * 1024 + (ob ^ (((ob >> 9) & 1) << 5)); }
__host__ __device__ __forceinline__ void stage_rc(int b, int& R, int& C) { const int st = b / 1024, sb = b % 1024, swz = sb ^ (((sb >> 9) & 1) << 5); R = (st >> 1) * 16 + swz / 64; C = (st & 1) * 32 + (swz % 64) / 2; }
__host__ __device__ __forceinline__ int perm32(int rho) { const int n = rho >> 4, i = rho & 15; return 8 * (i >> 2) + 4 * n + (i & 3); }

struct Unit { int pm, pn; };
struct Gemm { const bf16_t* A; const bf16_t* Bt; int M, N, K; };
struct StaticOrder {
    int nM, nN, nwg, G, c;
    __host__ __device__ void init(int M, int N, int G_, int c_) { nM = M / BM; nN = N / BM; nwg = nM * nN; G = G_; c = c_; }
    __host__ __device__ bool next(int i, Unit& u) const {
        const long L = (long)i * G + c; if (L >= nwg) return false;
        int wgid = (int)L; { const int q = nwg / NXCD, r = nwg % NXCD, xcd = wgid % NXCD, off = wgid / NXCD; wgid = (xcd < r ? xcd * (q + 1) : r * (q + 1) + (xcd - r) * q) + off; }
        const int nig = WGM * nN, gid = wgid / nig, fm = gid * WGM, gsz = (nM - fm) < WGM ? (nM - fm) : WGM;
        u.pm = fm + ((wgid % nig) % gsz); u.pn = (wgid % nig) / gsz; return true;
    }
    __device__ __forceinline__ void a_ready(const Unit&) const {}
    __device__ __forceinline__ void done(const Unit&) const {}
};

struct OrderIn : StaticOrder {
    int i0, i1;
    __device__ __forceinline__ bool next(int i, Unit& u) const {
        if (i0 + i >= i1) return false;
        if (!StaticOrder::next(i0 + i, u)) return false;
        u.pn = u.pn == 16 ? 9 : (u.pn == 9 ? 16 : u.pn);
        return true;
    }
};

template <class Epi, class Sched>
__device__ __forceinline__ void gemm_phase(LAS unsigned char* lds, const Gemm g, const Sched& S, const Epi& E, const int tid) {
    const int wid = __builtin_amdgcn_readfirstlane(tid >> 6), lane = tid & 63, wr = wid >> 2, wc = wid & 3, fr = lane & 15, fq = lane >> 4;
    const int K = g.K, nt = K / BK;
    unsigned voffA[2], voffB[2];
#pragma unroll
    for (int i = 0; i < 2; ++i) { int R, C; stage_rc(tid * 16 + i * 8192, R, C); const int Rb = 64 * (R >> 5) + perm32(R & 31);
        voffA[i] = (unsigned)(R * K + C) * 2u; voffB[i] = (unsigned)(Rb * K + C) * 2u; }
    const size_t kstep = (size_t)(BK * 2);
    const size_t hstep = (size_t)HALF * K * 2;
    const size_t hstepB = (size_t)32 * K * 2;
    const size_t tstep = 2 * hstep;
    const unsigned ldsw = (unsigned)wid * 1024u;
    const int aoff = lds_byte(wr * 64 + fr, fq * 8), boff = lds_byte(wc * 32 + fr, fq * 8);
#define PG8_SA(b, h) (((b) * 2 + (h)) * HTB)
#define PG8_SB(b, h) ((4 + (b) * 2 + (h)) * HTB)
#define PG8_STAGE(bufoff, gbase, voff) do { _Pragma("unroll") for (int _i = 0; _i < 2; ++_i) \
        __builtin_amdgcn_global_load_lds((const unsigned*)((const char*)(gbase) + (voff)[_i]), (LAS unsigned*)(lds + (bufoff) + ldsw + _i * 8192), 16, 0, 0); } while (0)
#define PG8_LDA(dst, b, h) do { _Pragma("unroll") for (int m = 0; m < 4; ++m) _Pragma("unroll") for (int k = 0; k < 2; ++k) dst[m][k] = *(const LAS bf16x8*)(lds + PG8_SA(b, h) + aoff + m * 2048 + k * 1024); } while (0)
#define PG8_LDB(dst, b, h) do { _Pragma("unroll") for (int n = 0; n < 2; ++n) _Pragma("unroll") for (int k = 0; k < 2; ++k) dst[n][k] = *(const LAS bf16x8*)(lds + PG8_SB(b, h) + boff + n * 2048 + k * 1024); } while (0)
#define PG8_MMA(ai, bj, At, Bt) do { __builtin_amdgcn_s_setprio(1); _Pragma("unroll") for (int m = 0; m < 4; ++m) _Pragma("unroll") for (int n = 0; n < 2; ++n) _Pragma("unroll") for (int k = 0; k < 2; ++k) \
        acc[ai][bj][m][n] = __builtin_amdgcn_mfma_f32_16x16x32_bf16(Bt[n][k], At[m][k], acc[ai][bj][m][n], 0, 0, 0); __builtin_amdgcn_s_setprio(0); } while (0)
#define PG8_WAIT_V(n) asm volatile("s_waitcnt vmcnt(" #n ")" ::: "memory")
#define PG8_WAIT_L(n) asm volatile("s_waitcnt lgkmcnt(" #n ")" ::: "memory")
#define PG8_BAR __builtin_amdgcn_s_barrier()
#define PG8_SCHED __builtin_amdgcn_sched_barrier(0)
    Unit cur, nxt; int ui = 0;
    if (!S.next(0, cur)) return;
    f32x4 acc[2][2][4][2];
#pragma unroll
    for (int a = 0; a < 2; ++a)
#pragma unroll
        for (int b = 0; b < 2; ++b)
#pragma unroll
            for (int m = 0; m < 4; ++m)
#pragma unroll
                for (int n = 0; n < 2; ++n) acc[a][b][m][n] = (f32x4){0.f, 0.f, 0.f, 0.f};
    bf16x8 At[4][2], B0[2][2], B1[2][2];
    const char* cA = (const char*)g.A + (size_t)cur.pm * tstep; const char* cB = (const char*)g.Bt + (size_t)cur.pn * tstep;
    S.a_ready(cur);
    PG8_STAGE(PG8_SB(0, 0), cB, voffB); PG8_STAGE(PG8_SB(0, 1), cB + hstepB, voffB); PG8_STAGE(PG8_SA(0, 0), cA, voffA); PG8_STAGE(PG8_SA(0, 1), cA + hstep, voffA);
    if (wr == 1) PG8_BAR;
    PG8_WAIT_V(2); PG8_BAR;
    PG8_STAGE(PG8_SB(1, 0), cB + kstep, voffB); PG8_STAGE(PG8_SA(1, 0), cA + kstep, voffA); PG8_STAGE(PG8_SB(1, 1), cB + hstepB + kstep, voffB);
    PG8_WAIT_V(6); PG8_BAR;
    for (;;) {
        const bool has_next = S.next(ui + 1, nxt);
        const char* nA = has_next ? (const char*)g.A + (size_t)nxt.pm * tstep : cA; const char* nB = has_next ? (const char*)g.Bt + (size_t)nxt.pn * tstep : cB;
        for (int t = 0; t < nt; t += 2) {
            const bool last = (t == nt - 2);
            const char* a1 = cA + (size_t)(t + 1) * kstep;
            const char* a2 = last ? nA : cA + (size_t)(t + 2) * kstep; const char* b2 = last ? nB : cB + (size_t)(t + 2) * kstep;
            const char* a3 = a2 + kstep; const char* b3 = b2 + kstep;
            if (last && has_next) S.a_ready(nxt);
            PG8_LDB(B0, 0, 0); PG8_LDB(B1, 0, 1); PG8_SCHED; PG8_LDA(At, 0, 0); PG8_STAGE(PG8_SA(1, 1), a1 + hstep, voffA);
            PG8_WAIT_V(8); PG8_WAIT_L(0); PG8_BAR; PG8_MMA(0, 0, At, B0); PG8_MMA(0, 1, At, B1); PG8_BAR; PG8_SCHED;
            PG8_LDA(At, 0, 1); PG8_STAGE(PG8_SB(0, 0), b2, voffB); PG8_STAGE(PG8_SB(0, 1), b2 + hstepB, voffB); PG8_STAGE(PG8_SA(0, 0), a2, voffA);
            PG8_WAIT_V(8); PG8_WAIT_L(0); PG8_BAR; PG8_MMA(1, 0, At, B0); PG8_MMA(1, 1, At, B1); PG8_BAR; PG8_SCHED;
            PG8_LDB(B0, 1, 0); PG8_LDB(B1, 1, 1); PG8_SCHED; PG8_LDA(At, 1, 0); PG8_STAGE(PG8_SA(0, 1), a2 + hstep, voffA);
            PG8_WAIT_V(8); PG8_WAIT_L(0); PG8_BAR; PG8_MMA(0, 0, At, B0); PG8_MMA(0, 1, At, B1); PG8_BAR; PG8_SCHED;
            PG8_LDA(At, 1, 1); PG8_STAGE(PG8_SB(1, 0), b3, voffB); PG8_STAGE(PG8_SB(1, 1), b3 + hstepB, voffB); PG8_STAGE(PG8_SA(1, 0), a3, voffA);
            PG8_WAIT_V(8); PG8_WAIT_L(0); PG8_BAR; PG8_MMA(1, 0, At, B0); PG8_MMA(1, 1, At, B1); PG8_BAR; PG8_SCHED;
        }
        if (wr == 0) PG8_BAR;
        E(acc, cur, wr, wc, fr, fq); S.done(cur);
        if (!has_next) break;
#pragma unroll
        for (int a = 0; a < 2; ++a)
#pragma unroll
            for (int b = 0; b < 2; ++b)
#pragma unroll
                for (int m = 0; m < 4; ++m)
#pragma unroll
                    for (int n = 0; n < 2; ++n) acc[a][b][m][n] = (f32x4){0.f, 0.f, 0.f, 0.f};
        cur = nxt; cA = nA; cB = nB; ++ui;
        if (wr == 1) PG8_BAR;
    }
    PG8_WAIT_V(0);
    PG8_BAR;
#undef PG8_SA
#undef PG8_SB
#undef PG8_STAGE
#undef PG8_LDA
#undef PG8_LDB
#undef PG8_MMA
#undef PG8_WAIT_V
#undef PG8_WAIT_L
#undef PG8_BAR
#undef PG8_SCHED
}

struct EpiIn {
    int layer; int nostore;
    __device__ __forceinline__ void operator()(const f32x4 (&acc)[2][2][4][2], const Unit& u, int wr, int wc, int fr, int fq) const {
        if (nostore) { float s_ = 0.f;
#pragma unroll
            for (int a = 0; a < 2; ++a)
#pragma unroll
                for (int b = 0; b < 2; ++b)
#pragma unroll
                    for (int m = 0; m < 4; ++m)
#pragma unroll
                        for (int n = 0; n < 2; ++n) s_ += acc[a][b][m][n][0] + acc[a][b][m][n][1] + acc[a][b][m][n][2] + acc[a][b][m][n][3];
            if (s_ == 123.456f) wsf(WS_GATES)[0] = s_;
            return; }
        const int pn = u.pn, jb = u.pm >> 4;
        const int cb = pn * 256 + wc * 64 + fq * 8;
        const float* ssq = wsf(WS_SSQ) + (size_t)layer * MPAD + u.pm * 256 + wr * 64 + fr;
        const float* bp = wsf(WS_BIAS) + ((size_t)layer * 10 + jb) * NIN + cb;
        f32x4 bv[2][2]; float rs[2][4];
#pragma unroll
        for (int bj = 0; bj < 2; ++bj)
#pragma unroll
            for (int n = 0; n < 2; ++n) bv[bj][n] = *(const f32x4*)(bp + 32 * bj + 4 * n);
#pragma unroll
        for (int ai = 0; ai < 2; ++ai)
#pragma unroll
            for (int m = 0; m < 4; ++m) rs[ai][m] = ssq[ai * 128 + m * 16];
        f32x4 gq[2][2];
        if (pn < 6) { const float* gp = (pn < 3 ? KIN(I_QNG) : KIN(I_KNG)) + layer * 64 + fq * 8;
#pragma unroll
            for (int bj = 0; bj < 2; ++bj)
#pragma unroll
                for (int n = 0; n < 2; ++n) gq[bj][n] = *(const f32x4*)(gp + 32 * bj + 4 * n); }
        bf16_t* proj = wsh(WS_PROJ); float* out = KOUT;
#pragma unroll
        for (int ai = 0; ai < 2; ++ai)
#pragma unroll
            for (int m = 0; m < 4; ++m) {
                const int row = u.pm * 256 + ai * 128 + wr * 64 + m * 16 + fr;
                const float rstd = rsqrtf(rs[ai][m] * (1.f / 2048.f) + EPS);
                f32x4 v[2][2];
#pragma unroll
                for (int bj = 0; bj < 2; ++bj)
#pragma unroll
                    for (int n = 0; n < 2; ++n) v[bj][n] = acc[ai][bj][m][n] * rstd + bv[bj][n];
                if (pn < 6) {
                    float ss = 0.f;
#pragma unroll
                    for (int bj = 0; bj < 2; ++bj)
#pragma unroll
                        for (int n = 0; n < 2; ++n) { const f32x4 x = v[bj][n]; ss += (x[0] * x[0] + x[1] * x[1]) + (x[2] * x[2] + x[3] * x[3]); }
                    ss += __shfl_xor(ss, 16); ss += __shfl_xor(ss, 32);
                    const float r = rsqrtf(ss * (1.f / 64.f) + EPS) * (pn < 3 ? 0.125f * 1.4426950408889634f : 1.f);
#pragma unroll
                    for (int bj = 0; bj < 2; ++bj)
#pragma unroll
                        for (int n = 0; n < 2; ++n) v[bj][n] = v[bj][n] * r * gq[bj][n];
                }
                if (pn < 33) {
#pragma unroll
                    for (int bj = 0; bj < 2; ++bj) {
                        u32x4 w; w.x = pk2(v[bj][0][0], v[bj][0][1]); w.y = pk2(v[bj][0][2], v[bj][0][3]); w.z = pk2(v[bj][1][0], v[bj][1][1]); w.w = pk2(v[bj][1][2], v[bj][1][3]);
                        *(u32x4*)(proj + (size_t)row * NPROJ + cb + 32 * bj) = w;
                    }
                }
                float* dst = nullptr;
                const int t = row & 4095;
                if (pn >= 3 && pn < 9 && t >= 2048) dst = out + (pn < 6 ? O_PK : O_PV) + (size_t)((layer * 2 + jb) * 2048 + (t - 2048)) * 768 + (cb - (pn < 6 ? C_KA : C_VA));
                if (pn >= 18 && pn < 24 && t >= 4093) dst = out + O_PCONV + (size_t)((layer * 2 + jb) * 3 + (t - 4093)) * 1536 + (cb - C_QKC);
                if (dst) {
#pragma unroll
                    for (int bj = 0; bj < 2; ++bj)
#pragma unroll
                        for (int n = 0; n < 2; ++n) *(f32x4*)(dst + 32 * bj + 4 * n) = v[bj][n];
                }
                if (pn == 33 && wc == 0 && fq < 2) {
                    const float* ibias = KIN(I_IB) + layer * 6; const float* fbias = KIN(I_FB) + layer * 6; float* gates = wsf(WS_GATES);
#pragma unroll
                    for (int n = 0; n < 2; ++n)
#pragma unroll
                        for (int i = 0; i < 4; ++i) { const int gi = 8 * fq + 4 * n + i;
                            if (gi < 12) { float val = v[0][n][i]; if (gi < 6) val += ibias[gi]; else val = logsigf(val + fbias[gi - 6]); gates[(size_t)row * 16 + gi] = val; } }
                }
            }
    }
};

struct EpiOut {
    int layer; int nostore;
    __device__ __forceinline__ void operator()(const f32x4 (&acc)[2][2][4][2], const Unit& u, int wr, int wc, int fr, int fq) const {
        if (nostore) { float s_ = 0.f;
#pragma unroll
            for (int a = 0; a < 2; ++a)
#pragma unroll
                for (int b = 0; b < 2; ++b)
#pragma unroll
                    for (int m = 0; m < 4; ++m)
#pragma unroll
                        for (int n = 0; n < 2; ++n) s_ += acc[a][b][m][n][0] + acc[a][b][m][n][1] + acc[a][b][m][n][2] + acc[a][b][m][n][3];
            if (s_ == 123.456f) wsf(WS_GATES)[0] = s_;
            return; }
        const int jb = u.pm >> 4, cb = u.pn * 256 + wc * 64 + fq * 8;
        const bool nxt = layer + 1 < DEPTH, first = layer == 0;
        const float* xin = KIN(I_XP); bf16_t* xb = wsh(WS_XB); float* out = KOUT;
        const float* gp = wsf(WS_MOD) + ((size_t)layer * 10 + jb) * 6144 + 4096 + cb;
        const float* ge = wsf(WS_GEFF) + ((size_t)(nxt ? layer + 1 : layer) * 10 + jb) * D + cb;
        float* ssq_next = wsf(WS_SSQ) + (size_t)(layer + 1) * MPAD; bf16_t* Anext = wsh(WS_A);
        f32x4 gv[2][2], gev[2][2];
#pragma unroll
        for (int bj = 0; bj < 2; ++bj)
#pragma unroll
            for (int n = 0; n < 2; ++n) { gv[bj][n] = *(const f32x4*)(gp + 32 * bj + 4 * n); gev[bj][n] = *(const f32x4*)(ge + 32 * bj + 4 * n); }
#pragma unroll
        for (int am = 0; am < 4; ++am) {
            const int ai = am >> 1;
            f32x4 xr[4][2][2];
            if (first) {
#pragma unroll
                for (int m = 2 * (am & 1); m < 2 * (am & 1) + 2; ++m) { const size_t ro = (size_t)(u.pm * 256 + ai * 128 + wr * 64 + m * 16 + fr) * D + cb;
#pragma unroll
                    for (int bj = 0; bj < 2; ++bj)
#pragma unroll
                        for (int n = 0; n < 2; ++n) xr[m][bj][n] = *(const f32x4*)(xin + ro + 32 * bj + 4 * n); }
            } else {
                u32x4 xw[4][2];
#pragma unroll
                for (int m = 2 * (am & 1); m < 2 * (am & 1) + 2; ++m) { const size_t ro = (size_t)(u.pm * 256 + ai * 128 + wr * 64 + m * 16 + fr) * D + cb;
#pragma unroll
                    for (int bj = 0; bj < 2; ++bj) xw[m][bj] = *(const u32x4*)(xb + ro + 32 * bj); }
#pragma unroll
                for (int m = 2 * (am & 1); m < 2 * (am & 1) + 2; ++m)
#pragma unroll
                    for (int bj = 0; bj < 2; ++bj) { const u32x4 w = xw[m][bj];
                        xr[m][bj][0] = (f32x4){bf2f(w.x & 0xffffu), bf2f(w.x >> 16), bf2f(w.y & 0xffffu), bf2f(w.y >> 16)};
                        xr[m][bj][1] = (f32x4){bf2f(w.z & 0xffffu), bf2f(w.z >> 16), bf2f(w.w & 0xffffu), bf2f(w.w >> 16)}; }
            }
#pragma unroll
            for (int m = 2 * (am & 1); m < 2 * (am & 1) + 2; ++m) {
                const int row = u.pm * 256 + ai * 128 + wr * 64 + m * 16 + fr;
                float ss = 0.f;
#pragma unroll
                for (int bj = 0; bj < 2; ++bj) {
                    f32x4 xn[2];
#pragma unroll
                    for (int n = 0; n < 2; ++n) { xn[n] = xr[m][bj][n] + gv[bj][n] * acc[ai][bj][m][n];
                        ss += (xn[n][0] * xn[n][0] + xn[n][1] * xn[n][1]) + (xn[n][2] * xn[n][2] + xn[n][3] * xn[n][3]); }
                    if (nxt) {
                        u32x4 w; w.x = pk2(xn[0][0], xn[0][1]); w.y = pk2(xn[0][2], xn[0][3]); w.z = pk2(xn[1][0], xn[1][1]); w.w = pk2(xn[1][2], xn[1][3]);
                        *(u32x4*)(xb + (size_t)row * D + cb + 32 * bj) = w;
                        const f32x4 a0 = xn[0] * gev[bj][0], a1 = xn[1] * gev[bj][1];
                        w.x = pk2(a0[0], a0[1]); w.y = pk2(a0[2], a0[3]); w.z = pk2(a1[0], a1[1]); w.w = pk2(a1[2], a1[3]);
                        *(u32x4*)(Anext + (size_t)row * D + cb + 32 * bj) = w;
                    } else {
                        *(f32x4*)(out + (size_t)row * D + cb + 32 * bj) = xn[0]; *(f32x4*)(out + (size_t)row * D + cb + 32 * bj + 4) = xn[1];
                    }
                }
                if (nxt) { ss += __shfl_xor(ss, 16); ss += __shfl_xor(ss, 32); if (fq == 0) atomicAdd(ssq_next + row, ss); }
            }
        }
    }
};
}

#define XB_TMO      128
#define XB_XCNT(j)  (256  + 64 * (j))
#define XB_XSUB(j)  (1280 + 64 * (j))
#define XB_XGEN(j)  (2304 + 64 * (j))
#define XB_TOP      3328
#define XB_TOPGEN   3392
#define XCD_BAR_WORDS 3456
#define XB_SPIN_CAP (1u << 18)
__device__ __forceinline__ unsigned xb_ld(unsigned* p)              { return __hip_atomic_load(p, __ATOMIC_RELAXED, __HIP_MEMORY_SCOPE_AGENT); }
__device__ __forceinline__ unsigned xb_add(unsigned* p, unsigned v) { return __hip_atomic_fetch_add(p, v, __ATOMIC_RELAXED, __HIP_MEMORY_SCOPE_AGENT); }
__device__ __forceinline__ unsigned xb_xcc_id() { return (unsigned)__builtin_amdgcn_s_getreg((3 << 11) | 20) & 0xFu; }
#define XB_SPIN(cond, bar) do { unsigned _sp = 0; while (cond) { __builtin_amdgcn_s_sleep(1); \
    if ((++_sp & 255u) == 0u) { if (xb_ld(&(bar)[XB_TMO])) break; if (_sp > XB_SPIN_CAP) { atomicAdd(&(bar)[XB_TMO], 1u); break; } } } } while (0)
struct XcdBarrier { unsigned* bar; unsigned x; volatile LAS unsigned* st; };
__device__ __forceinline__ XcdBarrier xcd_barrier_post(unsigned* bar, volatile LAS unsigned* st) {
    XcdBarrier b; b.bar = bar; b.x = xb_xcc_id(); b.st = st;
    if (threadIdx.x == 0) (void)xb_add(&bar[XB_XCNT(b.x)], 1u);
    return b;
}
__device__ __forceinline__ void xcd_barrier_complete(unsigned* bar, unsigned x, unsigned& nloc, unsigned& nx) {
    const unsigned G = gridDim.x * gridDim.y * gridDim.z;
    unsigned sum, cnt, mine, sp = 0u;
    for (;;) {
        sum = 0u; cnt = 0u; mine = 0u;
#pragma unroll
        for (unsigned j = 0; j < 16; ++j) { const unsigned c = xb_ld(&bar[XB_XCNT(j)]); sum += c; cnt += (c > 0u) ? 1u : 0u; mine = (j == x) ? c : mine; }
        if (sum == G) break;
        __builtin_amdgcn_s_sleep(1);
        if ((++sp & 255u) == 0u) { if (xb_ld(&bar[XB_TMO])) break; if (sp > XB_SPIN_CAP) { atomicAdd(&bar[XB_TMO], 1u); break; } }
    }
    nloc = mine > 0u ? mine : 1u; nx = cnt > 0u ? cnt : 1u;
}
__device__ __forceinline__ void xcd_barrier(const XcdBarrier& b) {
    asm volatile("s_waitcnt vmcnt(0)" ::: "memory");
    __syncthreads();
    if (threadIdx.x == 0) {
        unsigned* bar = b.bar;
        __builtin_amdgcn_s_waitcnt(0);
        unsigned nloc = b.st[0], nx = b.st[1];
        if (nloc == 0u) { xcd_barrier_complete(bar, b.x, nloc, nx); b.st[0] = nloc; b.st[1] = nx; }
        const unsigned old = xb_add(&bar[XB_XSUB(b.x)], 1u);
        const unsigned gen = old / nloc;
        if (old + 1u == (gen + 1u) * nloc) {
            __builtin_amdgcn_fence(__ATOMIC_RELEASE, "agent");
            asm volatile("s_waitcnt vmcnt(0)" ::: "memory");
            const unsigned og = xb_add(&bar[XB_TOP], 1u);
            const unsigned tg = og / nx;
            if (og + 1u == (tg + 1u) * nx) xb_add(&bar[XB_TOPGEN], 1u);
            else XB_SPIN(xb_ld(&bar[XB_TOPGEN]) == tg, bar);
            __builtin_amdgcn_fence(__ATOMIC_ACQUIRE, "agent");
            xb_add(&bar[XB_XGEN(b.x)], 1u);
            asm volatile("s_waitcnt vmcnt(0)" ::: "memory");
        } else {
            XB_SPIN(xb_ld(&bar[XB_XGEN(b.x)]) == gen, bar);
            __builtin_amdgcn_fence(__ATOMIC_ACQUIRE, "agent");
            asm volatile("s_waitcnt vmcnt(0)" ::: "memory");
        }
    }
    __syncthreads();
}

__device__ __forceinline__ void gemv10_chunk(const float* W, int N, int n0, const float* tab, float* part, int wave, int lane, int tid,
                                             float* outp, int out_ld, const float* addv) {
    const int c8 = lane & 7, r0 = lane >> 3;
    const float* wp = W + (size_t)(wave * 256 + r0 * 32) * N + n0 + 4 * c8;
    const float* tp = tab + wave * 256 + r0 * 32;
    f32x4 acc[10];
#pragma unroll
    for (int j = 0; j < 10; ++j) acc[j] = (f32x4){0.f, 0.f, 0.f, 0.f};
#pragma unroll 1
    for (int b = 0; b < 2; ++b) {
        f32x4 w[16];
#pragma unroll
        for (int i = 0; i < 16; ++i) w[i] = *(const f32x4*)(wp + (size_t)(16 * b + i) * N);
#pragma unroll
        for (int j = 0; j < 10; ++j) {
            f32x4 a = acc[j];
#pragma unroll
            for (int i4 = 0; i4 < 4; ++i4) { const f32x4 t4 = *(const f32x4*)(tp + j * 2048 + 16 * b + 4 * i4);
                a += (w[4 * i4] * t4[0] + w[4 * i4 + 1] * t4[1]) + (w[4 * i4 + 2] * t4[2] + w[4 * i4 + 3] * t4[3]); }
            acc[j] = a;
            asm volatile("" ::: "memory");
        }
    }
#pragma unroll
    for (int j = 0; j < 10; ++j)
#pragma unroll
        for (int e = 0; e < 4; ++e) { float v = acc[j][e]; v += __shfl_xor(v, 8); v += __shfl_xor(v, 16); v += __shfl_xor(v, 32); acc[j][e] = v; }
    if (lane < 8) {
#pragma unroll
        for (int j = 0; j < 10; ++j) *(f32x4*)(part + (wave * 10 + j) * 32 + 4 * c8) = acc[j];
    }
    __syncthreads();
    if (tid < 320) {
        const int j = tid >> 5, c = tid & 31;
        float s = 0.f;
#pragma unroll
        for (int w = 0; w < 8; ++w) s += part[(w * 10 + j) * 32 + c];
        outp[(size_t)j * out_ld + n0 + c] = s + (addv ? addv[n0 + c] : 0.f);
    }
    __syncthreads();
}

struct TrItem { const float* W; bf16_t* WT; int N, k0, n0; };
__device__ __forceinline__ void tr_load(f32x4 (&v)[16], const TrItem& t, int lane) {
    const int col = t.n0 + 4 * (lane & 15); const bool cv = col < t.N;
    const float* p = t.W + (size_t)(t.k0 + (lane >> 4)) * t.N + (cv ? col : 0);
#pragma unroll
    for (int i = 0; i < 16; ++i) v[i] = cv ? *(const f32x4*)(p + (size_t)(4 * i) * t.N) : (f32x4){0.f, 0.f, 0.f, 0.f};
}
__device__ __forceinline__ void tr_store(const f32x4 (&v)[16], float* scr, const TrItem& t, int lane) {
    const int cg = lane & 15, r0 = lane >> 4;
#pragma unroll
    for (int i = 0; i < 16; ++i) { const int r = 4 * i + r0; *(f32x4*)(scr + r * 64 + 4 * (cg ^ (2 * (r >> 3)))) = v[i]; }
    asm volatile("s_waitcnt lgkmcnt(0)" ::: "memory");
    const int c = lane & 7;
#pragma unroll
    for (int j = 0; j < 8; ++j) { const int n = (lane >> 3) + 8 * j; const float* s = scr + (8 * c) * 64 + 4 * ((n >> 2) ^ (2 * c)) + (n & 3);
        u32x4 o; o.x = pk2(s[0 * 64], s[1 * 64]); o.y = pk2(s[2 * 64], s[3 * 64]); o.z = pk2(s[4 * 64], s[5 * 64]); o.w = pk2(s[6 * 64], s[7 * 64]);
        *(u32x4*)(t.WT + (size_t)(t.n0 + n) * D + t.k0 + 8 * c) = o; }
    asm volatile("s_waitcnt lgkmcnt(0)" ::: "memory");
}
template <class Map>
__device__ __forceinline__ void transpose_run(Frame& F, int it0, int step, int NT, const Map& map) {
    float* scr = (float*)(F.lds + F.wave * 16384);
    int it = it0; if (it >= NT) return;
    f32x4 v[16]; TrItem c = map(it); tr_load(v, c, F.lane);
    for (;;) {
        const int nx = it + step; const bool hn = nx < NT;
        f32x4 w[16]; TrItem n_ = c;
        if (hn) { n_ = map(nx); tr_load(w, n_, F.lane); }
        tr_store(v, scr, c, F.lane);
        if (!hn) break;
#pragma unroll
        for (int i = 0; i < 16; ++i) v[i] = w[i];
        c = n_; it = nx;
    }
}
constexpr int WT_IN = 32 * 133, WT_OUT = 32 * 32;
struct MapIn { int l; __device__ __forceinline__ TrItem operator()(int it) const { const int kb = it / 133, nb = it - kb * 133;
    return TrItem{KIN(I_WIN) + (size_t)l * D * DIN, wsh(WS_WIN) + (size_t)l * NIN * D, DIN, 64 * kb, 64 * nb}; } };
struct MapAll { __device__ __forceinline__ TrItem operator()(int it) const { const int l = it / (WT_IN + WT_OUT), r = it - l * (WT_IN + WT_OUT);
    if (r < WT_IN) return MapIn{l}(r);
    const int q = r - WT_IN; return TrItem{KIN(I_WOUT) + (size_t)l * D * D, wsh(WS_WOUT) + (size_t)l * D * D, D, 64 * (q >> 5), 64 * (q & 31)}; } };

__device__ __forceinline__ void phase_p0(Frame& F) {
    float* tab = (float*)F.lds;
    float* part = (float*)(F.lds + 81920);
    { const float* cp = KIN(I_CP); const float* cs = KIN(I_CS);
      for (int o = F.tid; o < 10 * 2048; o += 512) { const int j = o >> 11, k = o & 2047; const float c = j < 2 ? cp[j * D + k] : cs[(j - 2) * D + k]; tab[o] = siluf(c); } }
    __syncthreads();
    for (int it = F.bx; it < DEPTH * 192; it += F.G) {
        const int l = it / 192, ch = it % 192;
        gemv10_chunk(KIN(I_ADAW) + (size_t)l * D * 6144, 6144, ch * 32, tab, part, F.wave, F.lane, F.tid, wsf(WS_MOD) + (size_t)l * 10 * 6144, 6144, KIN(I_ADAB) + (size_t)l * 6144);
    }
    __syncthreads();
    const int gw = F.vcu * 8 + F.wave, NGW = F.G * 8;
    transpose_run(F, gw, NGW, DEPTH * (WT_IN + WT_OUT), MapAll{});
    const int gt = F.bx * 512 + F.tid, NGT = F.G * 512;
    for (int l = 0; l < DEPTH; ++l) { u32x4* p = (u32x4*)(wsh(WS_WIN) + ((size_t)l * NIN + 8480) * D); for (int o = gt; o < 224 * D / 8; o += NGT) p[o] = (u32x4){0u, 0u, 0u, 0u}; }
    { float* bz = wsf(WS_BIAS); for (int o = gt; o < DEPTH * 10 * NIN; o += NGT) bz[o] = 0.f; }
    { float* sz = wsf(WS_SSQ); for (int o = gt; o < 5 * MPAD; o += NGT) sz[o] = 0.f; }
    { float* btab = wsf(WS_BT); const float* relb = KIN(I_RELB); const float* qg = KIN(I_QNG); const float* kg = KIN(I_KNG);
      for (int it = gw; it < DEPTH * 12; it += NGW) { const int l = it / 12, h = it % 12;
          const float G = wave_max(fabsf(qg[l * 64 + F.lane] * kg[l * 64 + F.lane]));
          const float mb_ = wave_max(relb[(F.lane & 31) * 12 + h]);
          const float M = 8.f * G + mb_;
          for (int o = F.lane; o < 3 * 132; o += 64) { const int p = o / 132, j = o % 132;
              btab[(size_t)((l * 3 + p) * 12 + h) * 132 + j] = j <= 128 ? (relb[(int)c_bucket[p][j] * 12 + h] - M) * 1.4426950408889634f : 0.f; } } }
    { const float* sw = KIN(I_SGUW); bf16_t* sg16 = wsh(WS_SGW); for (int o = gt; o < DEPTH * 4 * 128 * 128; o += NGT) { const int s_ = o & 127, t_ = (o >> 7) & 127; sg16[o] = (bf16_t)f2bf(s_ <= t_ ? sw[o] : 0.f); } }
}

__device__ __forceinline__ void bias_unit(Frame& F, int layer, int unit) {
    const int tid = fresh_tid(F), lane = tid & 63, wave = __builtin_amdgcn_readfirstlane(tid >> 6), hh = lane >> 5, l31 = lane & 31;
    const int n0 = unit * 64;
    const float* sh = wsf(WS_MOD) + ((size_t)layer * 10 + (l31 < 10 ? l31 : 0)) * 6144 + wave * 256 + 8 * hh;
    float* part = (float*)F.lds;
    f32x16 acc[2];
#pragma unroll
    for (int b = 0; b < 2; ++b)
#pragma unroll
        for (int i = 0; i < 16; ++i) acc[b][i] = 0.f;
    unsigned char* stg = F.lds + wave * 8192;
    const int lr = lane >> 3, lp = lane & 7;
    const bf16_t* bsrc = wsh(WS_WIN) + ((size_t)layer * NIN + n0 + lr) * D + wave * 256 + lp * 8;
    u32x4 sreg[8];
#pragma unroll
    for (int i = 0; i < 8; ++i) sreg[i] = *(const u32x4*)(bsrc + (size_t)(8 * i) * D);
    __syncthreads();
#pragma unroll 1
    for (int kb = 0; kb < 4; ++kb) {
#pragma unroll
        for (int i = 0; i < 8; ++i) { const int r = 8 * i + lr; *(u32x4*)(stg + r * 128 + ((lp ^ ((r >> 1) & 7)) << 4)) = sreg[i]; }
        if (kb < 3) {
#pragma unroll
            for (int i = 0; i < 8; ++i) sreg[i] = *(const u32x4*)(bsrc + (size_t)(8 * i) * D + 64 * (kb + 1));
        }
#pragma unroll
        for (int k4 = 0; k4 < 4; ++k4) { const int ko = (kb * 4 + k4) * 16;
            u32x4 pw = (u32x4){0u, 0u, 0u, 0u};
            if (l31 < 10) { const f32x4 s0 = *(const f32x4*)(sh + ko), s1 = *(const f32x4*)(sh + ko + 4); pw.x = pk2(s0[0], s0[1]); pw.y = pk2(s0[2], s0[3]); pw.z = pk2(s1[0], s1[1]); pw.w = pk2(s1[2], s1[3]); }
            const bf16x8 a = __builtin_bit_cast(bf16x8, pw);
#pragma unroll
            for (int ct = 0; ct < 2; ++ct) { const int rb = 32 * ct + l31;
                const bf16x8 b = *(const bf16x8*)(stg + rb * 128 + (((2 * k4 + hh) ^ ((rb >> 1) & 7)) << 4));
                acc[ct] = __builtin_amdgcn_mfma_f32_32x32x16_bf16(a, b, acc[ct], 0, 0, 0); }
        }
        asm volatile("s_waitcnt lgkmcnt(0)" ::: "memory");
    }
    __syncthreads();
#pragma unroll
    for (int ct = 0; ct < 2; ++ct)
#pragma unroll
        for (int i = 0; i < 16; ++i) part[(wave * 32 + (i & 3) + 8 * (i >> 2) + 4 * hh) * 68 + 32 * ct + l31] = acc[ct][i];
    __syncthreads();
    for (int o = tid; o < 640; o += 512) { const int j = o >> 6, c = o & 63; float v = 0.f;
#pragma unroll
        for (int w = 0; w < 8; ++w) v += part[(w * 32 + j) * 68 + c];
        wsf(WS_BIAS)[((size_t)layer * 10 + j) * NIN + n0 + c] = v; }
}

__device__ __forceinline__ void gate_unit(Frame& F, int layer, int unit) {
    const int tid = fresh_tid(F), lane = tid & 63, wave = __builtin_amdgcn_readfirstlane(tid >> 6), hh = lane >> 5, l31 = lane & 31;
    const int row0 = unit * 64;
    const bf16_t* wg = wsh(WS_WIN) + ((size_t)layer * NIN + 8448 + (l31 < 12 ? l31 : 0)) * D + wave * 256 + 8 * hh;
    float* part = (float*)F.lds;
    f32x16 acc[2];
#pragma unroll
    for (int b = 0; b < 2; ++b)
#pragma unroll
        for (int i = 0; i < 16; ++i) acc[b][i] = 0.f;
    unsigned char* stg = F.lds + wave * 8192;
    const int lr = lane >> 3, lp = lane & 7;
    const bf16_t* bsrc = wsh(WS_A) + (size_t)(row0 + lr) * D + wave * 256 + lp * 8;
    u32x4 sreg[8];
#pragma unroll
    for (int i = 0; i < 8; ++i) sreg[i] = *(const u32x4*)(bsrc + (size_t)(8 * i) * D);
    __syncthreads();
#pragma unroll 1
    for (int kb = 0; kb < 4; ++kb) {
#pragma unroll
        for (int i = 0; i < 8; ++i) { const int r = 8 * i + lr; *(u32x4*)(stg + r * 128 + ((lp ^ ((r >> 1) & 7)) << 4)) = sreg[i]; }
        if (kb < 3) {
#pragma unroll
            for (int i = 0; i < 8; ++i) sreg[i] = *(const u32x4*)(bsrc + (size_t)(8 * i) * D + 64 * (kb + 1));
        }
#pragma unroll
        for (int k4 = 0; k4 < 4; ++k4) { const int ko = (kb * 4 + k4) * 16;
            u32x4 pw = (u32x4){0u, 0u, 0u, 0u};
            if (l31 < 12) pw = *(const u32x4*)(wg + ko);
            const bf16x8 a = __builtin_bit_cast(bf16x8, pw);
#pragma unroll
            for (int ct = 0; ct < 2; ++ct) { const int rb = 32 * ct + l31;
                const bf16x8 b = *(const bf16x8*)(stg + rb * 128 + (((2 * k4 + hh) ^ ((rb >> 1) & 7)) << 4));
                acc[ct] = __builtin_amdgcn_mfma_f32_32x32x16_bf16(a, b, acc[ct], 0, 0, 0); }
        }
        asm volatile("s_waitcnt lgkmcnt(0)" ::: "memory");
    }
    __syncthreads();
#pragma unroll
    for (int ct = 0; ct < 2; ++ct)
#pragma unroll
        for (int i = 0; i < 16; ++i) part[(wave * 32 + (i & 3) + 8 * (i >> 2) + 4 * hh) * 68 + 32 * ct + l31] = acc[ct][i];
    __syncthreads();
    const float* ibias = KIN(I_IB) + layer * 6; const float* fbias = KIN(I_FB) + layer * 6; float* gates = wsf(WS_GATES);
    for (int o = tid; o < 768; o += 512) { const int j = o >> 6, c = o & 63, row = row0 + c; float v = 0.f;
#pragma unroll
        for (int w = 0; w < 8; ++w) v += part[(w * 32 + j) * 68 + c];
        const float rstd = rsqrtf(wsf(WS_SSQ)[(size_t)layer * MPAD + row] * (1.f / 2048.f) + EPS);
        float val = v * rstd + wsf(WS_BIAS)[((size_t)layer * 10 + (row >> 12)) * NIN + 8448 + j];
        if (j < 6) val += ibias[j]; else val = logsigf(val + fbias[j - 6]);
        gates[(size_t)row * 16 + j] = val; }
}

__device__ __forceinline__ void phase_p1(Frame& F, bool dynamic) {
    const int gt = F.bx * 512 + F.tid, NGT = F.G * 512;
    { float* geff = wsf(WS_GEFF); const float* mod = wsf(WS_MOD); const float* ng = KIN(I_NORMG);
      for (int o = gt; o < DEPTH * 10 * D; o += NGT) { const int k = o & 2047, lj = o >> 11, l = lj / 10; geff[o] = ng[l * D + k] * (1.f + mod[(size_t)lj * 6144 + 2048 + k]); } }
    const int gw = F.vcu * 8 + F.wave, NGW = F.G * 8;
    const float* xp_ = KIN(I_XP); const float* xs_ = KIN(I_XS); const float* mod0 = wsf(WS_MOD); const float* ng = KIN(I_NORMG); bf16_t* Ab = wsh(WS_A); float* ssq0 = wsf(WS_SSQ);
    const int NB1 = (F.G == 256) ? 5 : 133;
    const int U_BIAS = 133 + (DEPTH - 1) * NB1; constexpr int U_ROWS = MV / 32; const int U_TOT = U_BIAS + U_ROWS;
    unsigned* ctr = (unsigned*)(KA()->ws + WS_CTL) + CW_Q + 64 * 40;
    volatile unsigned* slot = (volatile unsigned*)(F.lds + LDSCTL_OFF + 64);
    unsigned pre = 0u;
    if (dynamic) { if (F.tid == 0) pre = __hip_atomic_fetch_add(ctr, 1u, __ATOMIC_RELAXED, __HIP_MEMORY_SCOPE_AGENT); } else pre = (unsigned)F.bx;
    for (;;) {
        unsigned uq;
        if (dynamic) { __syncthreads(); if (F.tid == 0) slot[0] = pre; __syncthreads(); uq = slot[0]; if (uq >= (unsigned)U_TOT) break;
            if (F.tid == 0) pre = __hip_atomic_fetch_add(ctr, 1u, __ATOMIC_RELAXED, __HIP_MEMORY_SCOPE_AGENT); }
        else { uq = pre; if (uq >= (unsigned)U_TOT) break; pre += (unsigned)F.G; }
        if (uq < (unsigned)U_BIAS) { if (uq < 133u) bias_unit(F, 0, (int)uq); else { const int r_ = (int)uq - 133; bias_unit(F, 1 + r_ / NB1, 133 - NB1 + r_ % NB1); } continue; }
    for (int row = ((int)uq - U_BIAS) * 32 + F.wave * 4, rend = row + 4; row < rend; ++row) {
        const int jb = row < MP ? (row >> 12) : 2 + ((row - MP) >> 3);
        const float* xr = row < MP ? xp_ + (size_t)row * D : xs_ + (size_t)(row - MP) * D;
        const float* sc = mod0 + (size_t)jb * 6144 + 2048;
        float ss = 0.f;
#pragma unroll
        for (int i = 0; i < 8; ++i) {
            const int c = (i * 64 + F.lane) * 4;
            const f32x4 x = *(const f32x4*)(xr + c), s = *(const f32x4*)(sc + c), g = *(const f32x4*)(ng + c);
            ss += (x[0] * x[0] + x[1] * x[1]) + (x[2] * x[2] + x[3] * x[3]);
            const f32x4 a = x * g * (s + 1.f);
            u32x2 w; w.x = pk2(a[0], a[1]); w.y = pk2(a[2], a[3]);
            *(u32x2*)(Ab + (size_t)row * D + c) = w;
        }
        ss = wave_sum(ss);
        if (F.lane == 0) ssq0[row] = ss;
    }
    }
    __syncthreads();
}

__device__ __forceinline__ void sattn_item(Frame& F, int layer, int it) {
    const int tid = fresh_tid(F), lane = tid & 63, wave = __builtin_amdgcn_readfirstlane(tid >> 6);
    const int t = it & 7, bhh = it >> 3, h = bhh % 12, bs = bhh / 12;
    const int mb = MP + bs * 8, m = mb + t, grp = lane >> 4, dl = lane & 15;
    const bf16_t* P = wsh(WS_PROJ);
    float* wsc = (float*)(F.lds + wave * 4096);
    { const float* relb = KIN(I_RELB);
#pragma unroll
      for (int i = 0; i < 7; ++i) { const int e = lane + 64 * i; if (e < 387) { const int p = (e >= 129) + (e >= 258), j = e - 129 * p; wsc[e] = relb[(int)c_bucket[p][j] * 12 + h] * 1.4426950408889634f; } } }
    const float* ck = KIN(I_CK) + ((size_t)(layer * 8 + bs) * 2048) * 768 + h * 64 + dl * 4;
    const float* cvp = KIN(I_CV) + ((size_t)(layer * 8 + bs) * 2048) * 768 + h * 64 + dl * 4;
    const bf16_t* pk = P + (size_t)mb * NPROJ + C_KA + h * 64 + dl * 4;
    const bf16_t* pv = P + (size_t)mb * NPROJ + C_VA + h * 64 + dl * 4;
    float q0, q1, q2, q3;
    { const u32x2 w = *(const u32x2*)(P + (size_t)m * NPROJ + h * 64 + dl * 4); q0 = bf2f(w.x & 0xffffu); q1 = bf2f(w.x >> 16); q2 = bf2f(w.y & 0xffffu); q3 = bf2f(w.y >> 16); }
    float m_run = -INFINITY, l_run = 0.f; f32x4 o = (f32x4){0.f, 0.f, 0.f, 0.f};
#pragma unroll 1
    for (int i0 = 0; i0 < 112; i0 += 16) {
        f32x4 kv[16], vv[16];
#pragma unroll
        for (int ii = 0; ii < 16; ++ii) {
            int e = 4 * (i0 + ii) + grp; e = e > 386 ? 386 : e;
            const int p = (e >= 129) + (e >= 258), j = e - 129 * p, tk = 2048 + t - (j << (2 * p));
            if (tk < 2048) { kv[ii] = *(const f32x4*)(ck + (size_t)tk * 768); vv[ii] = *(const f32x4*)(cvp + (size_t)tk * 768); }
            else { const u32x2 w = *(const u32x2*)(pk + (size_t)(tk - 2048) * NPROJ), x = *(const u32x2*)(pv + (size_t)(tk - 2048) * NPROJ);
                kv[ii] = (f32x4){bf2f(w.x & 0xffffu), bf2f(w.x >> 16), bf2f(w.y & 0xffffu), bf2f(w.y >> 16)}; vv[ii] = (f32x4){bf2f(x.x & 0xffffu), bf2f(x.x >> 16), bf2f(x.y & 0xffffu), bf2f(x.y >> 16)}; }
        }
        float sc[16]; float cm = -INFINITY;
#pragma unroll
        for (int ii = 0; ii < 16; ++ii) {
            float s_ = q0 * kv[ii][0] + q1 * kv[ii][1] + q2 * kv[ii][2] + q3 * kv[ii][3];
            s_ += __shfl_xor(s_, 1); s_ += __shfl_xor(s_, 2); s_ += __shfl_xor(s_, 4); s_ += __shfl_xor(s_, 8);
            const int e = 4 * (i0 + ii) + grp;
            sc[ii] = e < 387 ? s_ + wsc[e] : -INFINITY; cm = fmaxf(cm, sc[ii]);
        }
        const float mn = fmaxf(m_run, cm);
        const float scale = __builtin_amdgcn_exp2f(m_run - mn);
        l_run *= scale; o = o * scale;
#pragma unroll
        for (int ii = 0; ii < 16; ++ii) { const float pe = __builtin_amdgcn_exp2f(sc[ii] - mn); l_run += pe; o += vv[ii] * pe; }
        m_run = mn;
    }
    { float M = fmaxf(m_run, __shfl_xor(m_run, 16)); M = fmaxf(M, __shfl_xor(M, 32));
      const float f = __builtin_amdgcn_exp2f(m_run - M); l_run *= f; o = o * f;
      l_run += __shfl_xor(l_run, 16); l_run += __shfl_xor(l_run, 32);
#pragma unroll
      for (int c = 0; c < 4; ++c) { float x = o[c]; x += __shfl_xor(x, 16); x += __shfl_xor(x, 32); o[c] = x; } }
    if (grp == 0) {
        const u32x2 zw = *(const u32x2*)(P + (size_t)m * NPROJ + C_ZA + h * 64 + dl * 4);
        const float il = 1.f / l_run;
        u32x2 y; y.x = pk2(o[0] * il * siluf(bf2f(zw.x & 0xffffu)), o[1] * il * siluf(bf2f(zw.x >> 16))); y.y = pk2(o[2] * il * siluf(bf2f(zw.y & 0xffffu)), o[3] * il * siluf(bf2f(zw.y >> 16)));
        *(u32x2*)(wsh(WS_YMIX) + (size_t)m * D + h * 64 + dl * 4) = y;
    }
}

__device__ __forceinline__ v4i16_t lds_tr16(const unsigned char* p) { return __builtin_amdgcn_ds_read_tr16_b64_v4i16((LAS v4i16_t*)p); }
__device__ __forceinline__ bf16x8 tr_frag_nat(const unsigned char* img, int ld, int k0, int n0, int lane) {
    const int g4 = lane >> 4, c0 = 16 * (g4 & 1), hh = g4 >> 1, q4 = (lane & 15) >> 2, p4 = lane & 3;
    const unsigned char* p = img + (k0 + 8 * hh + q4) * ld + (n0 + c0 + 4 * p4) * 2;
    const v4i16_t a = lds_tr16(p), b = lds_tr16(p + 4 * ld);
    return (bf16x8){a[0], a[1], a[2], a[3], b[0], b[1], b[2], b[3]};
}
__device__ __forceinline__ bf16x8 tr_frag_acc(const unsigned char* img, int ld, int k0, int n0, int lane) {
    const int g4 = lane >> 4, c0 = 16 * (g4 & 1), hh = g4 >> 1, q4 = (lane & 15) >> 2, p4 = lane & 3;
    const unsigned char* p = img + (k0 + 4 * hh + q4) * ld + (n0 + c0 + 4 * p4) * 2;
    const v4i16_t a = lds_tr16(p), b = lds_tr16(p + 8 * ld);
    return (bf16x8){a[0], a[1], a[2], a[3], b[0], b[1], b[2], b[3]};
}
__device__ __forceinline__ bf16x8 pack_acc8(const f32x16& x, int s2) {
    u32x4 pw; pw.x = pk2(x[8 * s2 + 0], x[8 * s2 + 1]); pw.y = pk2(x[8 * s2 + 2], x[8 * s2 + 3]); pw.z = pk2(x[8 * s2 + 4], x[8 * s2 + 5]); pw.w = pk2(x[8 * s2 + 6], x[8 * s2 + 7]);
    return __builtin_bit_cast(bf16x8, pw);
}
__device__ __forceinline__ void wave_cumsum128(float* arr, int lane) {
    const float a = arr[2 * lane], b = arr[2 * lane + 1], s = a + b; float inc = s;
#pragma unroll
    for (int o = 1; o < 64; o <<= 1) { const float t = __shfl_up(inc, o); if (lane >= o) inc += t; }
    const float exc = inc - s; arr[2 * lane] = exc + a; arr[2 * lane + 1] = exc + s;
}
__device__ __forceinline__ void wave_cummax128(float* arr, int lane) {
    const float a = arr[2 * lane], b = arr[2 * lane + 1], s = fmaxf(a, b); float inc = s;
#pragma unroll
    for (int o = 1; o < 64; o <<= 1) { const float t = __shfl_up(inc, o); if (lane >= o) inc = fmaxf(inc, t); }
    float exc = __shfl_up(inc, 1); if (lane == 0) exc = -INFINITY;
    arr[2 * lane] = fmaxf(exc, a); arr[2 * lane + 1] = fmaxf(exc, s);
}
constexpr int IMG_LD = 320;

struct AttnHalf { u32x4 k[2], v[2], qv[2]; };
__device__ __forceinline__ void attn_issue(AttnHalf& R, const bf16_t* P, int mb, int h, int dil, int r, int n, int tid, bool with_q) {
#pragma unroll
    for (int it = 0; it < 2; ++it) {
        const int pid = it * 512 + tid, row = pid >> 3, ch = pid & 7;
        const bf16_t* rp = P + (size_t)(mb + (n * 128 + row) * dil + r) * NPROJ + h * 64 + ch * 8;
        R.k[it] = *(const u32x4*)(rp + C_KA); R.v[it] = *(const u32x4*)(rp + C_VA);
        if (with_q) R.qv[it] = *(const u32x4*)(rp);
    }
}
__device__ __forceinline__ void attn_put(unsigned char* half, const AttnHalf& R, int tid) {
#pragma unroll
    for (int it = 0; it < 2; ++it) { const int pid = it * 512 + tid, row = pid >> 3, ch = pid & 7;
        *(u32x4*)(half + row * 128 + ((ch ^ ((row >> 1) & 7)) << 4)) = R.k[it];
        *(u32x4*)(half + 16384 + row * 128 + ch * 16) = R.v[it]; }
}
template <int PAR>
__device__ __forceinline__ void attn_unit(unsigned char* lds0, const bf16_t* P, AttnHalf& R, int layer, int p, int mb, int h, int dil, int r, int n, int n_pre,
                                          int tid, int lane, int qt, int kh, int q, int hh) {
    unsigned char* up = lds0 + PAR * 32768; unsigned char* lo = lds0 + (PAR ^ 1) * 32768;
    unsigned char* qimg = lds0 + 116736;
    const float* bt2 = (const float*)(lds0 + 65536);
    float* part = (float*)(lds0 + 66560); float* partl = part + 4 * 16 * 2 * 64;
    unsigned char* ost = lds0 + 100352 + qt * 4096;
    __syncthreads();
    attn_put(up, R, tid);
#pragma unroll
    for (int it = 0; it < 2; ++it) { const int pid = it * 512 + tid, row = pid >> 3, ch = pid & 7; *(u32x4*)(qimg + row * 128 + ((ch ^ ((row >> 1) & 7)) << 4)) = R.qv[it]; }
    __syncthreads();
    if (n_pre >= 0) attn_issue(R, P, mb, h, dil, r, n_pre, tid, true);
    bf16x8 qf[4];
    { const int qrow = 32 * qt + q;
#pragma unroll
      for (int s_ = 0; s_ < 4; ++s_) qf[s_] = *(const bf16x8*)(qimg + qrow * 128 + (((2 * s_ + hh) ^ ((qrow >> 1) & 7)) << 4)); }
    f32x16 o0, o1;
#pragma unroll
    for (int e = 0; e < 16; ++e) { o0[e] = 0.f; o1[e] = 0.f; }
    float lsum = 0.f;
#pragma unroll
    for (int k3 = 0; k3 < 3; ++k3) {
        const int kk = kh ? 3 + k3 : k3;
        if (kh && k3 == 2) continue;
        const int kt = qt + kk;
        if (n == 0 && kt < 4) continue;
        const unsigned char* hb = kt < 4 ? lo : up;
        f32x16 st;
#pragma unroll
        for (int e = 0; e < 16; ++e) st[e] = bt2[160 - 32 * kk + q - ((e & 3) + 8 * (e >> 2) + 4 * hh)];
        const int krow = 32 * (kt & 3) + q;
#pragma unroll
        for (int s_ = 0; s_ < 4; ++s_) {
            const bf16x8 kf = *(const bf16x8*)(hb + krow * 128 + (((2 * s_ + hh) ^ ((krow >> 1) & 7)) << 4));
            st = __builtin_amdgcn_mfma_f32_32x32x16_bf16(kf, qf[s_], st, 0, 0, 0);
        }
#pragma unroll
        for (int e = 0; e < 16; ++e) { const float pe = __builtin_amdgcn_exp2f(st[e]); lsum += pe; st[e] = pe; }
#pragma unroll
        for (int s2 = 0; s2 < 2; ++s2) {
            const bf16x8 pa = pack_acc8(st, s2);
            const bf16x8 v0 = tr_frag_acc(hb + 16384, 128, 32 * (kt & 3) + 16 * s2, 0, lane), v1 = tr_frag_acc(hb + 16384, 128, 32 * (kt & 3) + 16 * s2, 32, lane);
            o0 = __builtin_amdgcn_mfma_f32_32x32x16_bf16(pa, v0, o0, 0, 0, 0);
            o1 = __builtin_amdgcn_mfma_f32_32x32x16_bf16(pa, v1, o1, 0, 0, 0);
        }
    }
    lsum += __shfl_xor(lsum, 32);
    if (kh) {
#pragma unroll
        for (int e = 0; e < 16; ++e) { part[((qt * 16 + e) * 2 + 0) * 64 + lane] = o0[e]; part[((qt * 16 + e) * 2 + 1) * 64 + lane] = o1[e]; }
        partl[qt * 64 + lane] = lsum;
    }
    __syncthreads();
    if (!kh) {
#pragma unroll
        for (int e = 0; e < 16; ++e) { o0[e] += part[((qt * 16 + e) * 2 + 0) * 64 + lane]; o1[e] += part[((qt * 16 + e) * 2 + 1) * 64 + lane]; }
        lsum += partl[qt * 64 + lane];
        const int mq = mb + ((n * 128 + 32 * qt + q) * dil + r);
        if (hh == 0) wsf(WS_LA)[((size_t)p * MP + mq) * 12 + h] = lsum;
#pragma unroll
        for (int e = 0; e < 16; ++e) {
            const int qq = (e & 3) + 8 * (e >> 2) + 4 * hh;
            *(bf16_t*)(ost + qq * 128 + q * 2) = (bf16_t)f2bf(o0[e]); *(bf16_t*)(ost + qq * 128 + 64 + q * 2) = (bf16_t)f2bf(o1[e]);
        }
        asm volatile("s_waitcnt lgkmcnt(0)" ::: "memory");
        const int qq = lane >> 1, half = lane & 1;
        bf16_t* op = wsh(WS_OA) + (size_t)p * MP * 768 + (size_t)(mb + r + (n * 128 + 32 * qt + qq) * dil) * 768 + h * 64 + half * 32;
#pragma unroll
        for (int e = 0; e < 4; ++e) *(u32x4*)(op + 8 * e) = *(const u32x4*)(ost + qq * 128 + half * 64 + 16 * e);
    }
}
constexpr int ATT_JOBS = 24 * 32;
__device__ __forceinline__ void attn_job(Frame& F, int layer, int job) {
    const int tid = fresh_tid(F), lane = tid & 63, wave = __builtin_amdgcn_readfirstlane(tid >> 6), qt = wave & 3, kh = wave >> 2, q = lane & 31, hh = lane >> 5;
    const int bh = job < 384 ? (job >> 4) : ((job - 384) >> 4), jj = job < 384 ? (job & 15) : 16 + ((job - 384) & 15), h = bh % 12, b = bh / 12, mb = b * SEQ;
    int p, r, n0, len;
    if (jj < 8) { p = 0; r = 0; n0 = 4 * jj; len = 4; } else if (jj < 16) { p = 1; r = (jj - 8) >> 1; n0 = 4 * (jj & 1); len = 4; } else { p = 2; r = jj - 16; n0 = 0; len = 2; }
    const int dil = 1 << (2 * p);
    float* bt = (float*)(F.lds + 65536);
    const bf16_t* P = wsh(WS_PROJ);
    AttnHalf RA, RB;
    attn_issue(RA, P, mb, h, dil, r, n0, tid, true);
    attn_issue(RB, P, mb, h, dil, r, n0 + 1, tid, true);
    __syncthreads();
    if (tid < 192) { const int j = tid - 32; bt[tid] = (j >= 0 && j <= 128) ? wsf(WS_BT)[(size_t)((layer * 3 + p) * 12 + h) * 132 + j] : -INFINITY; }
    if (n0 > 0) { AttnHalf RL; attn_issue(RL, P, mb, h, dil, r, n0 - 1, tid, false); attn_put(F.lds + 32768, RL, tid); }
#pragma unroll 1
    for (int i = 0; i < len; i += 2) {
        attn_unit<0>(F.lds, P, RA, layer, p, mb, h, dil, r, n0 + i, i + 2 < len ? n0 + i + 2 : -1, tid, lane, qt, kh, q, hh);
        attn_unit<1>(F.lds, P, RB, layer, p, mb, h, dil, r, n0 + i + 1, i + 3 < len ? n0 + i + 3 : -1, tid, lane, qt, kh, q, hh);
    }
    __syncthreads();
}
__device__ __forceinline__ void attn_combine_row(Frame& F, int m) {
    const bf16_t* OA = wsh(WS_OA); const float* LA = wsf(WS_LA); const bf16_t* P = wsh(WS_PROJ); bf16_t* Y = wsh(WS_YMIX);
    u32x2 o0[3], o1[3], o2[3], zz[3]; float L[3];
#pragma unroll
    for (int i = 0; i < 3; ++i) {
        const int c = (F.lane + 64 * i) * 4, hd = c >> 6;
        o0[i] = *(const u32x2*)(OA + (size_t)m * 768 + c); o1[i] = *(const u32x2*)(OA + ((size_t)MP + m) * 768 + c); o2[i] = *(const u32x2*)(OA + ((size_t)2 * MP + m) * 768 + c);
        zz[i] = *(const u32x2*)(P + (size_t)m * NPROJ + C_ZA + c);
        L[i] = LA[(size_t)m * 12 + hd] + LA[((size_t)MP + m) * 12 + hd] + LA[((size_t)2 * MP + m) * 12 + hd];
    }
#pragma unroll
    for (int i = 0; i < 3; ++i) {
        const int c = (F.lane + 64 * i) * 4; const float il = 1.f / L[i];
        const float a0 = (bf2f(o0[i].x & 0xffffu) + bf2f(o1[i].x & 0xffffu) + bf2f(o2[i].x & 0xffffu)) * il * siluf(bf2f(zz[i].x & 0xffffu));
        const float a1 = (bf2f(o0[i].x >> 16) + bf2f(o1[i].x >> 16) + bf2f(o2[i].x >> 16)) * il * siluf(bf2f(zz[i].x >> 16));
        const float a2 = (bf2f(o0[i].y & 0xffffu) + bf2f(o1[i].y & 0xffffu) + bf2f(o2[i].y & 0xffffu)) * il * siluf(bf2f(zz[i].y & 0xffffu));
        const float a3 = (bf2f(o0[i].y >> 16) + bf2f(o1[i].y >> 16) + bf2f(o2[i].y >> 16)) * il * siluf(bf2f(zz[i].y >> 16));
        u32x2 y; y.x = pk2(a0, a1); y.y = pk2(a2, a3);
        *(u32x2*)(Y + (size_t)m * D + c) = y;
    }
}

__device__ __forceinline__ void sgu_unit(Frame& F, int layer, int m0, int L, int g, float* sgu_out  ) {
    float* Wt = (float*)F.lds;
    float* vn = (float*)(F.lds + 65536);
    float* rs = (float*)(F.lds + 131072);
    const bf16_t* P = wsh(WS_PROJ); bf16_t* Y = wsh(WS_YMIX); const int tid = fresh_tid(F);
    __syncthreads();
    { const int r = tid >> 2, sub = tid & 3;
      float ss = 0.f;
      if (r < L) { const bf16_t* vp = P + (size_t)(m0 + r) * NPROJ + C_VB + sub * 128;
          for (int c = 0; c < 128; c += 8) { const u32x4 w = *(const u32x4*)(vp + c);
              const float a0 = bf2f(w.x & 0xffffu), a1 = bf2f(w.x >> 16), a2 = bf2f(w.y & 0xffffu), a3 = bf2f(w.y >> 16), a4 = bf2f(w.z & 0xffffu), a5 = bf2f(w.z >> 16), a6 = bf2f(w.w & 0xffffu), a7 = bf2f(w.w >> 16);
              ss += a0 * a0 + a1 * a1 + a2 * a2 + a3 * a3 + a4 * a4 + a5 * a5 + a6 * a6 + a7 * a7; } }
      ss += __shfl_xor(ss, 1); ss += __shfl_xor(ss, 2);
      if (r < L && sub == 0) rs[r] = rsqrtf(ss * (1.f / 512.f) + EPS); }
    __syncthreads();
    const float* sw = KIN(I_SGUW) + ((size_t)(layer * 4 + g)) * 128 * 128;
    const float* sg = KIN(I_SGUG) + layer * 512 + g * 128;
    for (int o = tid; o < L * 128; o += 512) {
        const int s = o >> 7, c = o & 127;
        const float v = bf2f(P[(size_t)(m0 + s) * NPROJ + C_VB + g * 128 + c]) * rs[s] * sg[c];
        vn[o] = v;
        if (sgu_out) sgu_out[(size_t)s * 512 + g * 128 + c] = v;
    }
    for (int o = tid; o < L * 128; o += 512) { const int t = o >> 7, s = o & 127; Wt[o] = (s <= t && s < L) ? sw[t * 128 + s] : 0.f; }
    __syncthreads();
    const int c = tid & 127, tq = tid >> 7;
    const float* sb = KIN(I_SGUB) + (layer * 4 + g) * 128;
    for (int t = tq; t < L; t += 4) {
        float acc = 0.f;
        for (int s = 0; s <= t; ++s) acc += Wt[t * 128 + s] * vn[s * 128 + c];
        const float mix = acc + sb[t];
        const size_t pr = (size_t)(m0 + t) * NPROJ;
        const float u = bf2f(P[pr + C_UB + g * 128 + c]), z = bf2f(P[pr + C_ZB + g * 128 + c]);
        Y[(size_t)(m0 + t) * D + 768 + g * 128 + c] = (bf16_t)f2bf(u * mix * siluf(z));
    }
    __syncthreads();
}

__device__ __forceinline__ void sgu_unit_mfma(Frame& F, int layer, int m0, int g) {
    unsigned char* vimg = F.lds;
    float* hbuf = (float*)(F.lds + 40960);
    const bf16_t* P = wsh(WS_PROJ); const int tid = fresh_tid(F), lane = tid & 63, wave = __builtin_amdgcn_readfirstlane(tid >> 6);
    const int r = tid >> 2, sub = tid & 3;
    const bf16_t* vp = P + (size_t)(m0 + r) * NPROJ + C_VB + sub * 128;
    const int tt = wave & 3, ct0 = (wave >> 2) * 2, tl = lane & 31, hh = lane >> 5, t = 32 * tt + tl;
    bf16x8 wf[4][2];
    { const bf16_t* sw = wsh(WS_SGW) + ((size_t)(layer * 4 + g)) * 128 * 128 + (size_t)t * 128 + 8 * hh;
#pragma unroll
      for (int st = 0; st < 4; ++st) if (st <= tt) {
#pragma unroll
          for (int s2 = 0; s2 < 2; ++s2) wf[st][s2] = *(const bf16x8*)(sw + 32 * st + 16 * s2); } }
    float ss = 0.f;
#pragma unroll
    for (int c = 0; c < 16; ++c) { const u32x4 w = *(const u32x4*)(vp + 8 * c);
        const float a0 = bf2f(w.x & 0xffffu), a1 = bf2f(w.x >> 16), a2 = bf2f(w.y & 0xffffu), a3 = bf2f(w.y >> 16), a4 = bf2f(w.z & 0xffffu), a5 = bf2f(w.z >> 16), a6 = bf2f(w.w & 0xffffu), a7 = bf2f(w.w >> 16);
        ss += a0 * a0 + a1 * a1 + a2 * a2 + a3 * a3 + a4 * a4 + a5 * a5 + a6 * a6 + a7 * a7; }
    ss += __shfl_xor(ss, 1); ss += __shfl_xor(ss, 2);
    const float rr = rsqrtf(ss * (1.f / 512.f) + EPS);
    __syncthreads();
    if (sub == g) {
#pragma unroll
        for (int c = 0; c < 16; ++c) { const u32x4 w = *(const u32x4*)(vp + 8 * c); u32x4 o;
            o.x = pk2(bf2f(w.x & 0xffffu) * rr, bf2f(w.x >> 16) * rr); o.y = pk2(bf2f(w.y & 0xffffu) * rr, bf2f(w.y >> 16) * rr);
            o.z = pk2(bf2f(w.z & 0xffffu) * rr, bf2f(w.z >> 16) * rr); o.w = pk2(bf2f(w.w & 0xffffu) * rr, bf2f(w.w >> 16) * rr);
            *(u32x4*)(vimg + r * IMG_LD + c * 16) = o; } }
    __syncthreads();
    {   f32x16 a0, a1;
#pragma unroll
        for (int i = 0; i < 16; ++i) { a0[i] = 0.f; a1[i] = 0.f; }
#pragma unroll
        for (int st = 0; st < 4; ++st) if (st <= tt) {
#pragma unroll
            for (int s2 = 0; s2 < 2; ++s2) {
                const bf16x8 af = wf[st][s2];
                const bf16x8 b0 = tr_frag_nat(vimg, IMG_LD, 32 * st + 16 * s2, 32 * ct0, lane), b1 = tr_frag_nat(vimg, IMG_LD, 32 * st + 16 * s2, 32 * ct0 + 32, lane);
                a0 = __builtin_amdgcn_mfma_f32_32x32x16_bf16(af, b0, a0, 0, 0, 0);
                a1 = __builtin_amdgcn_mfma_f32_32x32x16_bf16(af, b1, a1, 0, 0, 0);
            }
        }
#pragma unroll
        for (int i = 0; i < 16; ++i) { const int tr_ = 32 * tt + (i & 3) + 8 * (i >> 2) + 4 * hh;
            hbuf[tr_ * 132 + 32 * ct0 + tl] = a0[i]; hbuf[tr_ * 132 + 32 * ct0 + 32 + tl] = a1[i]; }
    }
    const int tp = tid >> 2, part = tid & 3;
    const bf16_t* pu = P + (size_t)(m0 + tp) * NPROJ + C_UB + g * 128 + part * 32; const bf16_t* pz = P + (size_t)(m0 + tp) * NPROJ + C_ZB + g * 128 + part * 32;
    const float* sg = KIN(I_SGUG) + layer * 512 + g * 128 + part * 32;
    const float bv = KIN(I_SGUB)[(layer * 4 + g) * 128 + tp];
    u32x4 uwv[4], zwv[4]; f32x4 gv[8];
#pragma unroll
    for (int i = 0; i < 4; ++i) { uwv[i] = *(const u32x4*)(pu + 8 * i); zwv[i] = *(const u32x4*)(pz + 8 * i); gv[2 * i] = *(const f32x4*)(sg + 8 * i); gv[2 * i + 1] = *(const f32x4*)(sg + 8 * i + 4); }
    __syncthreads();
    {   bf16_t* py = wsh(WS_YMIX) + (size_t)(m0 + tp) * D + 768 + g * 128 + part * 32;
#pragma unroll
        for (int i = 0; i < 4; ++i) {
            const u32x4 uw = uwv[i], zw = zwv[i];
            const f32x4 a = *(const f32x4*)(hbuf + tp * 132 + part * 32 + 8 * i) * gv[2 * i] + bv, c = *(const f32x4*)(hbuf + tp * 132 + part * 32 + 8 * i + 4) * gv[2 * i + 1] + bv;
            u32x4 y;
            y.x = pk2(bf2f(uw.x & 0xffffu) * a[0] * siluf(bf2f(zw.x & 0xffffu)), bf2f(uw.x >> 16) * a[1] * siluf(bf2f(zw.x >> 16)));
            y.y = pk2(bf2f(uw.y & 0xffffu) * a[2] * siluf(bf2f(zw.y & 0xffffu)), bf2f(uw.y >> 16) * a[3] * siluf(bf2f(zw.y >> 16)));
            y.z = pk2(bf2f(uw.z & 0xffffu) * c[0] * siluf(bf2f(zw.z & 0xffffu)), bf2f(uw.z >> 16) * c[1] * siluf(bf2f(zw.z >> 16)));
            y.w = pk2(bf2f(uw.w & 0xffffu) * c[2] * siluf(bf2f(zw.w & 0xffffu)), bf2f(uw.w >> 16) * c[3] * siluf(bf2f(zw.w >> 16)));
            *(u32x4*)(py + 8 * i) = y;
        }
    }
    __syncthreads();
}

struct ConvP { const bf16_t* proj; const float* cw; const float* cb; const float* sconv; };
__device__ __forceinline__ ConvP conv_ptrs(int layer) { ConvP c; c.proj = wsh(WS_PROJ); c.cw = KIN(I_CONVW) + (size_t)layer * 4 * 1536; c.cb = KIN(I_CONVB) + layer * 1536; c.sconv = KIN(I_SCONV) + (size_t)layer * 8 * 3 * 1536; return c; }
template <bool SAMPLE>
__device__ __forceinline__ float conv_qk(const ConvP& cp, int mbase, int bs, int t, int col) {
    const float* cw = cp.cw + col;
    float a = cp.cb[col];
#pragma unroll
    for (int j = 0; j < 4; ++j) {
        const int tt = t - 3 + j; float x;
        if (tt >= 0) x = bf2f(cp.proj[(size_t)(mbase + tt) * NPROJ + C_QKC + col]);
        else x = SAMPLE ? cp.sconv[((size_t)bs * 3 + (tt + 3)) * 1536 + col] : 0.f;
        a += cw[j * 1536] * x;
    }
    return siluf(a);
}

__device__ __forceinline__ void m1_unit(Frame& F, int layer, int u) {
    const int n = u & 31, bh = u >> 5, h = bh % 6, b = bh / 6, tid = fresh_tid(F), lane = tid & 63, wave = __builtin_amdgcn_readfirstlane(tid >> 6);
    const int mbase = b * SEQ, t0 = n * 128, m0 = mbase + t0;
    unsigned char* kimg = F.lds; unsigned char* vimg = F.lds + 40960;
    float* ws = (float*)(F.lds + 81920); float* dnp = ws + 128;
    const bf16_t* P = wsh(WS_PROJ);
    const int cg = tid & 15, rg = tid >> 4, colq = h * 128 + cg * 8, colk = 768 + colq;
    u32x4 vreg[4];
#pragma unroll
    for (int i = 0; i < 4; ++i) { const int pid = i * 512 + tid, row = pid >> 4, ch = pid & 15; vreg[i] = *(const u32x4*)(P + (size_t)(m0 + row) * NPROJ + C_VC + h * 128 + ch * 8); }
    u32x4 xq[7], xk[7];
#pragma unroll
    for (int i = 0; i < 7; ++i) { const int tt = t0 + 4 * rg - 3 + i;
        xq[i] = (u32x4){0u, 0u, 0u, 0u}; xk[i] = (u32x4){0u, 0u, 0u, 0u};
        if (tt >= 0) { const bf16_t* rp = P + (size_t)(mbase + tt) * NPROJ + C_QKC; xq[i] = *(const u32x4*)(rp + colq); xk[i] = *(const u32x4*)(rp + colk); } }
    const float* cwl = KIN(I_CONVW) + (size_t)layer * 4 * 1536; const float* cbl = KIN(I_CONVB) + layer * 1536;
    f32x4 wq[4][2], wk[4][2], bq[2], bk[2];
#pragma unroll
    for (int j = 0; j < 4; ++j) { wq[j][0] = *(const f32x4*)(cwl + j * 1536 + colq); wq[j][1] = *(const f32x4*)(cwl + j * 1536 + colq + 4); wk[j][0] = *(const f32x4*)(cwl + j * 1536 + colk); wk[j][1] = *(const f32x4*)(cwl + j * 1536 + colk + 4); }
    bq[0] = *(const f32x4*)(cbl + colq); bq[1] = *(const f32x4*)(cbl + colq + 4); bk[0] = *(const f32x4*)(cbl + colk); bk[1] = *(const f32x4*)(cbl + colk + 4);
    float ig0 = 0.f, ig1 = 0.f, lf0 = 0.f, lf1 = 0.f;
    if (wave == 0) { const float* GT = wsf(WS_GATES) + (size_t)(m0 + 2 * lane) * 16; ig0 = GT[h]; lf0 = GT[6 + h]; ig1 = GT[16 + h]; lf1 = GT[16 + 6 + h]; }
    __syncthreads();
    if (wave == 0) {
        const float sp = lf0 + lf1; float inc = sp;
#pragma unroll
        for (int o = 1; o < 64; o <<= 1) { const float t = __shfl_up(inc, o); if (lane >= o) inc += t; }
        const float c0 = inc - sp + lf0, c1 = inc;
        const float bl = rdlane_f(c1, 63);
        const float g0 = bl - c0 + ig0, g1 = bl - c1 + ig1;
        const float gm = wave_max(fmaxf(g0, g1));
        ws[2 * lane] = __expf(g0 - gm); ws[2 * lane + 1] = __expf(g1 - gm);
        if (lane == 0) { float* SCp = wsf(WS_SCAL); SCp[(size_t)u * 4 + 0] = gm; SCp[(size_t)u * 4 + 1] = bl; }
    }
#pragma unroll
    for (int i = 0; i < 4; ++i) { const int pid = i * 512 + tid, row = pid >> 4, ch = pid & 15; *(u32x4*)(vimg + row * IMG_LD + ch * 16) = vreg[i]; }
    float kc[4][8];
    {   bf16_t* QCb = wsh(WS_QC) + (size_t)(m0 + 4 * rg) * 768 + colq; bf16_t* KCb = wsh(WS_KC) + (size_t)(m0 + 4 * rg) * 768 + colq;
#pragma unroll
        for (int rr = 0; rr < 4; ++rr) {
            float a[8], c[8];
#pragma unroll
            for (int e = 0; e < 8; ++e) { a[e] = bq[e >> 2][e & 3]; c[e] = bk[e >> 2][e & 3]; }
#pragma unroll
            for (int j = 0; j < 4; ++j) { const u32x4 x = xq[rr + j], y = xk[rr + j];
                a[0] += wq[j][0][0] * bf2f(x.x & 0xffffu); a[1] += wq[j][0][1] * bf2f(x.x >> 16); a[2] += wq[j][0][2] * bf2f(x.y & 0xffffu); a[3] += wq[j][0][3] * bf2f(x.y >> 16);
                a[4] += wq[j][1][0] * bf2f(x.z & 0xffffu); a[5] += wq[j][1][1] * bf2f(x.z >> 16); a[6] += wq[j][1][2] * bf2f(x.w & 0xffffu); a[7] += wq[j][1][3] * bf2f(x.w >> 16);
                c[0] += wk[j][0][0] * bf2f(y.x & 0xffffu); c[1] += wk[j][0][1] * bf2f(y.x >> 16); c[2] += wk[j][0][2] * bf2f(y.y & 0xffffu); c[3] += wk[j][0][3] * bf2f(y.y >> 16);
                c[4] += wk[j][1][0] * bf2f(y.z & 0xffffu); c[5] += wk[j][1][1] * bf2f(y.z >> 16); c[6] += wk[j][1][2] * bf2f(y.w & 0xffffu); c[7] += wk[j][1][3] * bf2f(y.w >> 16); }
#pragma unroll
            for (int e = 0; e < 8; ++e) { a[e] = siluf(a[e]); kc[rr][e] = siluf(c[e]) * 0.08838834764831845f; }
            u32x4 o; o.x = pk2(a[0], a[1]); o.y = pk2(a[2], a[3]); o.z = pk2(a[4], a[5]); o.w = pk2(a[6], a[7]);
            *(u32x4*)(QCb + (size_t)rr * 768) = o;
            o.x = pk2(kc[rr][0], kc[rr][1]); o.y = pk2(kc[rr][2], kc[rr][3]); o.z = pk2(kc[rr][4], kc[rr][5]); o.w = pk2(kc[rr][6], kc[rr][7]);
            *(u32x4*)(KCb + (size_t)rr * 768) = o;
        }
    }
    __syncthreads();
    {   float dsum[8];
#pragma unroll
        for (int e = 0; e < 8; ++e) dsum[e] = 0.f;
#pragma unroll
        for (int rr = 0; rr < 4; ++rr) { const int s = 4 * rg + rr; const float wv = ws[s];
            u32x4 ow; ow.x = pk2(kc[rr][0] * wv, kc[rr][1] * wv); ow.y = pk2(kc[rr][2] * wv, kc[rr][3] * wv); ow.z = pk2(kc[rr][4] * wv, kc[rr][5] * wv); ow.w = pk2(kc[rr][6] * wv, kc[rr][7] * wv);
            *(u32x4*)(kimg + s * IMG_LD + cg * 16) = ow;
#pragma unroll
            for (int e = 0; e < 8; ++e) dsum[e] += kc[rr][e] * wv; }
#pragma unroll
        for (int e = 0; e < 8; ++e) { float x = dsum[e]; x += __shfl_xor(x, 16); x += __shfl_xor(x, 32); dsum[e] = x; }
        if ((lane >> 4) == 0) {
#pragma unroll
            for (int e = 0; e < 8; ++e) dnp[wave * 128 + cg * 8 + e] = dsum[e]; }
    }
    __syncthreads();
    {
        const int kt = wave >> 1, vt0 = 2 * (wave & 1);
        f32x16 d0, d1;
#pragma unroll
        for (int i = 0; i < 16; ++i) { d0[i] = 0.f; d1[i] = 0.f; }
#pragma unroll
        for (int ks = 0; ks < 8; ++ks) {
            const bf16x8 af = tr_frag_nat(kimg, IMG_LD, 16 * ks, 32 * kt, lane);
            const bf16x8 b0 = tr_frag_nat(vimg, IMG_LD, 16 * ks, 32 * vt0, lane), b1 = tr_frag_nat(vimg, IMG_LD, 16 * ks, 32 * vt0 + 32, lane);
            d0 = __builtin_amdgcn_mfma_f32_32x32x16_bf16(af, b0, d0, 0, 0, 0);
            d1 = __builtin_amdgcn_mfma_f32_32x32x16_bf16(af, b1, d1, 0, 0, 0);
        }
        float* dc = wsf(WS_DC) + (size_t)u * 16384;
        const int hh = lane >> 5, vv = lane & 31;
#pragma unroll
        for (int i = 0; i < 16; ++i) { const int k = 32 * kt + (i & 3) + 8 * (i >> 2) + 4 * hh;
            dc[k * 128 + 32 * vt0 + vv] = d0[i]; dc[k * 128 + 32 * vt0 + 32 + vv] = d1[i]; }
    }
    if (tid < 128) { float s_ = 0.f;
#pragma unroll
        for (int w = 0; w < 8; ++w) s_ += dnp[w * 128 + tid];
        wsf(WS_DN)[(size_t)u * 128 + tid] = s_; }
    __syncthreads();
}

__device__ __forceinline__ void phase_m2(Frame& F, int layer) {
    float* ca = (float*)F.lds; float* cb = ca + 32; float* cm = cb + 32;
    float* DNp = wsf(WS_DN); float* DCp = wsf(WS_DC); float* SCp = wsf(WS_SCAL); float* outp = KOUT; bf16_t* CBp = wsh(WS_CB);
    for (int u = F.bx; u < 12 * 33; u += F.G) {
        const int bh = u / 33, c = u % 33, b = bh / 6, h = bh % 6;
        __syncthreads();
        if (F.wave == 0) {
            const int ln = F.lane & 31;
            const float gmv = SCp[(size_t)(bh * 32 + ln) * 4 + 0], blv = SCp[(size_t)(bh * 32 + ln) * 4 + 1];
            float mm = 0.f, a_ = 0.f, b_ = 0.f, me = 0.f;
#pragma unroll
            for (int n = 0; n < 32; ++n) {
                const float g = rdlane_f(gmv, n), bl = rdlane_f(blv, n);
                const float mn = fmaxf(bl + mm, g);
                if (ln == n) { a_ = __expf(bl + mm - mn); b_ = __expf(g - mn); me = mm; }
                mm = mn;
            }
            if (F.lane < 32) { ca[ln] = a_; cb[ln] = b_; cm[ln] = me; if (c == 0) SCp[(size_t)(bh * 32 + ln) * 4 + 2] = me; }
            if (F.lane == 0) { cm[32] = mm; if (c == 0) outp[O_PM + (layer * 2 + b) * 6 + h] = mm; }
        }
        __syncthreads();
        if (c < 32) {
            const int e = c * 512 + F.tid;
            const float* base = DCp + (size_t)bh * 32 * 16384 + e;
            bf16_t* cbp = CBp + (size_t)bh * 32 * 16384 + e;
            float d[32];
#pragma unroll
            for (int n = 0; n < 32; ++n) d[n] = base[(size_t)n * 16384];
            float C = 0.f;
#pragma unroll
            for (int n = 0; n < 32; ++n) { cbp[(size_t)n * 16384] = (bf16_t)f2bf(C); C = ca[n] * C + cb[n] * d[n]; }
            outp[O_PC + ((size_t)((layer * 2 + b) * 6 + h)) * 16384 + e] = C;
        } else if (F.tid < 128) {
            float* base = DNp + (size_t)bh * 32 * 128 + F.tid;
            float d[32];
#pragma unroll
            for (int n = 0; n < 32; ++n) d[n] = base[n * 128];
            float C = 0.f;
            float* ne = wsf(WS_NE) + (size_t)bh * 32 * 128 + F.tid;
#pragma unroll
            for (int n = 0; n < 32; ++n) { ne[n * 128] = C; C = ca[n] * C + cb[n] * d[n]; }
            outp[O_PN + ((size_t)((layer * 2 + b) * 6 + h)) * 128 + F.tid] = C;
        }
    }
    __syncthreads();
}

__device__ __forceinline__ void m3_unit(Frame& F, int layer, int u) {
    const int n = u & 31, bh = u >> 5, h = bh % 6, b = bh / 6, tid = fresh_tid(F), lane = tid & 63, wave = __builtin_amdgcn_readfirstlane(tid >> 6);
    const int mbase = b * SEQ, m0 = mbase + n * 128;
    unsigned char* vimg = F.lds; unsigned char* cimg = F.lds + 40960;
    unsigned char* kimg = F.lds + 81920; unsigned char* qimg = F.lds + 81920 + 32768;
    float* hbuf = (float*)(F.lds + 81920);
    float* av = (float*)(F.lds + 149504); float* cv = av + 128; float* wi = cv + 128; float* emt = wi + 128; float* nst = emt + 128; float* dent = nst + 128;
    const bf16_t* P = wsh(WS_PROJ);
    const int tt = wave & 3, vh = wave >> 2, tl = lane & 31, hh = lane >> 5, t = 32 * tt + tl;
    u32x4 vreg[4], creg[4], kreg[4], qreg[4];
    {   const bf16_t* CBp = wsh(WS_CB) + (size_t)u * 16384;
        const bf16_t* QCb = wsh(WS_QC) + (size_t)m0 * 768 + h * 128; const bf16_t* KCb = wsh(WS_KC) + (size_t)m0 * 768 + h * 128;
#pragma unroll
        for (int i = 0; i < 4; ++i) { const int pid = i * 512 + tid, row = pid >> 4, ch = pid & 15;
            vreg[i] = *(const u32x4*)(P + (size_t)(m0 + row) * NPROJ + C_VC + h * 128 + ch * 8);
            creg[i] = *(const u32x4*)(CBp + row * 128 + ch * 8);
            kreg[i] = *(const u32x4*)(KCb + (size_t)row * 768 + ch * 8);
            qreg[i] = *(const u32x4*)(QCb + (size_t)row * 768 + ch * 8); } }
    const float m_n = wsf(WS_SCAL)[(size_t)u * 4 + 2];
    float ig0 = 0.f, ig1 = 0.f, lf0 = 0.f, lf1 = 0.f, nreg = 0.f;
    if (wave == 0) { const float* GT = wsf(WS_GATES) + (size_t)(m0 + 2 * lane) * 16; ig0 = GT[h]; lf0 = GT[6 + h]; ig1 = GT[16 + h]; lf1 = GT[16 + 6 + h]; }
    if (tid < 128) nreg = wsf(WS_NE)[(size_t)u * 128 + tid];
    __syncthreads();
#pragma unroll
    for (int i = 0; i < 4; ++i) { const int pid = i * 512 + tid, row = pid >> 4, ch = pid & 15;
        *(u32x4*)(vimg + row * IMG_LD + ch * 16) = vreg[i]; *(u32x4*)(cimg + row * IMG_LD + ch * 16) = creg[i];
        *(u32x4*)(kimg + row * 256 + ((ch ^ (row & 15)) << 4)) = kreg[i]; *(u32x4*)(qimg + row * 256 + ((ch ^ (row & 15)) << 4)) = qreg[i]; }
    if (tid < 128) nst[tid] = nreg;
    if (wave == 0) {
        const float sp = lf0 + lf1; float inc = sp;
#pragma unroll
        for (int o = 1; o < 64; o <<= 1) { const float x = __shfl_up(inc, o); if (lane >= o) inc += x; }
        const float c0 = inc - sp + lf0, c1 = inc;
        const float x0 = ig0 - c0, x1 = ig1 - c1, sx = fmaxf(x0, x1); float mxi = sx;
#pragma unroll
        for (int o = 1; o < 64; o <<= 1) { const float x = __shfl_up(mxi, o); if (lane >= o) mxi = fmaxf(mxi, x); }
        float exc = __shfl_up(mxi, 1); if (lane == 0) exc = -INFINITY;
        const float p0 = fmaxf(exc, x0), p1 = fmaxf(exc, sx);
        const float mt0 = c0 + fmaxf(m_n, p0), mt1 = c1 + fmaxf(m_n, p1);
        cv[2 * lane] = x0; cv[2 * lane + 1] = x1;
        av[2 * lane] = c0 - mt0; av[2 * lane + 1] = c1 - mt1;
        wi[2 * lane] = __expf(c0 + m_n - mt0); wi[2 * lane + 1] = __expf(c1 + m_n - mt1);
        emt[2 * lane] = __expf(-mt0); emt[2 * lane + 1] = __expf(-mt1);
    }
    __syncthreads();
    f32x16 H0, H1;
    {
        bf16x8 qf[8];
#pragma unroll
        for (int ks = 0; ks < 8; ++ks) qf[ks] = *(const bf16x8*)(qimg + t * 256 + (((2 * ks + hh) ^ (t & 15)) << 4));
#pragma unroll
        for (int i = 0; i < 16; ++i) { H0[i] = 0.f; H1[i] = 0.f; }
        float rowsum = 0.f;
        const float at = av[t];
#pragma unroll 1
        for (int st = 0; st <= tt; ++st) {
            f32x16 X;
#pragma unroll
            for (int i = 0; i < 16; ++i) X[i] = 0.f;
            const int krow = 32 * st + tl;
#pragma unroll
            for (int ks = 0; ks < 8; ++ks) { const bf16x8 kf = *(const bf16x8*)(kimg + krow * 256 + (((2 * ks + hh) ^ (krow & 15)) << 4)); X = __builtin_amdgcn_mfma_f32_32x32x16_bf16(kf, qf[ks], X, 0, 0, 0); }
#pragma unroll
            for (int i = 0; i < 16; ++i) { const int sl = (i & 3) + 8 * (i >> 2) + 4 * hh;
                const bool ok = (st < tt) || (sl <= tl);
                const float val = ok ? __expf(at + cv[32 * st + sl]) * X[i] : 0.f;
                rowsum += val; X[i] = val; }
#pragma unroll
            for (int s2 = 0; s2 < 2; ++s2) { const bf16x8 pa = pack_acc8(X, s2);
                const bf16x8 v0 = tr_frag_acc(vimg, IMG_LD, 32 * st + 16 * s2, 64 * vh, lane), v1 = tr_frag_acc(vimg, IMG_LD, 32 * st + 16 * s2, 64 * vh + 32, lane);
                H0 = __builtin_amdgcn_mfma_f32_32x32x16_bf16(pa, v0, H0, 0, 0, 0);
                H1 = __builtin_amdgcn_mfma_f32_32x32x16_bf16(pa, v1, H1, 0, 0, 0); }
        }
        rowsum += __shfl_xor(rowsum, 32);
        const float w = wi[t];
        float qn = 0.f;
#pragma unroll
        for (int ks = 0; ks < 8; ++ks) {
            u32x4 qw = __builtin_bit_cast(u32x4, qf[ks]);
            const float q0 = bf2f(qw.x & 0xffffu), q1 = bf2f(qw.x >> 16), q2 = bf2f(qw.y & 0xffffu), q3 = bf2f(qw.y >> 16), q4_ = bf2f(qw.z & 0xffffu), q5 = bf2f(qw.z >> 16), q6 = bf2f(qw.w & 0xffffu), q7 = bf2f(qw.w >> 16);
            const float* np = nst + 16 * ks + 8 * hh;
            qn += q0 * np[0] + q1 * np[1] + q2 * np[2] + q3 * np[3] + q4_ * np[4] + q5 * np[5] + q6 * np[6] + q7 * np[7];
            qw.x = pk2(q0 * w, q1 * w); qw.y = pk2(q2 * w, q3 * w); qw.z = pk2(q4_ * w, q5 * w); qw.w = pk2(q6 * w, q7 * w);
            qf[ks] = __builtin_bit_cast(bf16x8, qw);
        }
        qn += __shfl_xor(qn, 32);
        if (hh == 0) dent[vh * 128 + t] = fmaxf(fabsf(rowsum + w * qn), emt[t]);
#pragma unroll
        for (int ks = 0; ks < 8; ++ks) {
            const bf16x8 c0 = tr_frag_nat(cimg, IMG_LD, 16 * ks, 64 * vh, lane), c1 = tr_frag_nat(cimg, IMG_LD, 16 * ks, 64 * vh + 32, lane);
            H0 = __builtin_amdgcn_mfma_f32_32x32x16_bf16(qf[ks], c0, H0, 0, 0, 0);
            H1 = __builtin_amdgcn_mfma_f32_32x32x16_bf16(qf[ks], c1, H1, 0, 0, 0);
        }
    }
    const int tp = tid >> 2, part = tid & 3;
    const float* hg = KIN(I_HNG) + layer * 768 + h * 128 + part * 32;
    const bf16_t* po = P + (size_t)(m0 + tp) * NPROJ + C_OC + h * 128 + part * 32; const bf16_t* pz = P + (size_t)(m0 + tp) * NPROJ + C_ZC + h * 128 + part * 32;
    u32x4 owv[4], zwv[4]; f32x4 gv[8];
#pragma unroll
    for (int i = 0; i < 4; ++i) { owv[i] = *(const u32x4*)(po + 8 * i); zwv[i] = *(const u32x4*)(pz + 8 * i); gv[2 * i] = *(const f32x4*)(hg + 8 * i); gv[2 * i + 1] = *(const f32x4*)(hg + 8 * i + 4); }
    __syncthreads();
#pragma unroll
    for (int i = 0; i < 16; ++i) { const int tr_ = 32 * tt + (i & 3) + 8 * (i >> 2) + 4 * hh; const float dinv = 1.f / dent[vh * 128 + tr_];
        hbuf[tr_ * 132 + 64 * vh + tl] = H0[i] * dinv; hbuf[tr_ * 132 + 64 * vh + 32 + tl] = H1[i] * dinv; }
    __syncthreads();
    {
        f32x4 x[8]; float ss = 0.f;
#pragma unroll
        for (int i = 0; i < 8; ++i) { x[i] = *(const f32x4*)(hbuf + tp * 132 + part * 32 + 4 * i); ss += (x[i][0] * x[i][0] + x[i][1] * x[i][1]) + (x[i][2] * x[i][2] + x[i][3] * x[i][3]); }
        ss += __shfl_xor(ss, 1); ss += __shfl_xor(ss, 2);
        const float rs = rsqrtf(ss * (1.f / 128.f) + EPS);
        bf16_t* py = wsh(WS_YMIX) + (size_t)(m0 + tp) * D + 1280 + h * 128 + part * 32;
#pragma unroll
        for (int i = 0; i < 4; ++i) {
            const u32x4 ow = owv[i], zw = zwv[i];
            const f32x4 g0 = gv[2 * i], g1 = gv[2 * i + 1];
            const f32x4 a = x[2 * i], c = x[2 * i + 1];
            u32x4 y;
            y.x = pk2(a[0] * rs * g0[0] * sigmf(bf2f(ow.x & 0xffffu)) * siluf(bf2f(zw.x & 0xffffu)), a[1] * rs * g0[1] * sigmf(bf2f(ow.x >> 16)) * siluf(bf2f(zw.x >> 16)));
            y.y = pk2(a[2] * rs * g0[2] * sigmf(bf2f(ow.y & 0xffffu)) * siluf(bf2f(zw.y & 0xffffu)), a[3] * rs * g0[3] * sigmf(bf2f(ow.y >> 16)) * siluf(bf2f(zw.y >> 16)));
            y.z = pk2(c[0] * rs * g1[0] * sigmf(bf2f(ow.z & 0xffffu)) * siluf(bf2f(zw.z & 0xffffu)), c[1] * rs * g1[1] * sigmf(bf2f(ow.z >> 16)) * siluf(bf2f(zw.z >> 16)));
            y.w = pk2(c[2] * rs * g1[2] * sigmf(bf2f(ow.w & 0xffffu)) * siluf(bf2f(zw.w & 0xffffu)), c[3] * rs * g1[3] * sigmf(bf2f(ow.w >> 16)) * siluf(bf2f(zw.w >> 16)));
            *(u32x4*)(py + 8 * i) = y;
        }
    }
    __syncthreads();
}

__device__ __forceinline__ void ms_unit(Frame& F, int layer, int u) {
    const int h = u % 6, b = u / 6, tid = fresh_tid(F), lane = tid & 63, wave = __builtin_amdgcn_readfirstlane(tid >> 6), m0 = MP + b * 8;
    float* qs = (float*)F.lds; float* ks = qs + 1024; float* vs = ks + 1024; float* hb = vs + 1024;
    float* ig = hb + 1024; float* bhv = ig + 8; float* mt = bhv + 8; float* den = mt + 8; float* wsv = den + 8; float* Am = wsv + 8; float* misc = Am + 64; float* nq = misc + 8;
    float* cpart = nq + 8;
    const float* C0 = KIN(I_SC) + ((size_t)((layer * 8 + b) * 6 + h)) * 16384;
    const float* n0 = KIN(I_SN) + ((size_t)((layer * 8 + b) * 6 + h)) * 128;
    const float m0s = KIN(I_SM)[(layer * 8 + b) * 6 + h];
    const ConvP cp = conv_ptrs(layer); const float* GT = wsf(WS_GATES); float* outp = KOUT;
    const int v = tid & 127, kq = tid >> 7;
    float creg[32];
#pragma unroll
    for (int i = 0; i < 32; ++i) creg[i] = C0[(32 * kq + i) * 128 + v];
    __syncthreads();
    if (tid < 8) { ig[tid] = GT[(size_t)(m0 + tid) * 16 + h]; bhv[tid] = GT[(size_t)(m0 + tid) * 16 + 6 + h]; }
    for (int o = tid; o < 1024; o += 512) { const int t = o >> 7, c = o & 127;
        qs[o] = conv_qk<true>(cp, m0, b, t, h * 128 + c);
        ks[o] = conv_qk<true>(cp, m0, b, t, 768 + h * 128 + c) * 0.08838834764831845f;
        vs[o] = bf2f(cp.proj[(size_t)(m0 + t) * NPROJ + C_VC + h * 128 + c]); }
    __syncthreads();
    if (tid == 0) {
        float c = 0.f; for (int s = 0; s < 8; ++s) { c += bhv[s]; bhv[s] = c; }
        for (int t = 0; t < 8; ++t) { float mxx = bhv[t] + m0s; for (int s = 0; s <= t; ++s) mxx = fmaxf(mxx, bhv[t] - bhv[s] + ig[s]); mt[t] = mxx; }
        const float bl = bhv[7]; float mn = bl + m0s;
        for (int s = 0; s < 8; ++s) mn = fmaxf(mn, bl - bhv[s] + ig[s]);
        for (int s = 0; s < 8; ++s) wsv[s] = __expf(bl - bhv[s] + ig[s] - mn);
        misc[0] = mn; misc[1] = __expf(bl + m0s - mn);
        outp[O_SM + (layer * 8 + b) * 6 + h] = mn;
    }
    {
        const int d = tid >> 3, part = tid & 7, t = d >> 3, s_ = d & 7;
        float dot = 0.f, dn_ = 0.f;
#pragma unroll
        for (int k = 0; k < 16; ++k) { const float qv = qs[t * 128 + 16 * part + k]; dot += qv * ks[s_ * 128 + 16 * part + k]; if (s_ == 0) dn_ += qv * n0[16 * part + k]; }
        dot += __shfl_xor(dot, 1); dot += __shfl_xor(dot, 2); dot += __shfl_xor(dot, 4);
        dn_ += __shfl_xor(dn_, 1); dn_ += __shfl_xor(dn_, 2); dn_ += __shfl_xor(dn_, 4);
        __syncthreads();
        if (part == 0) { Am[d] = (s_ <= t) ? __expf(bhv[t] - bhv[s_] + ig[s_] - mt[t]) * dot : 0.f; if (s_ == 0) nq[t] = dn_; }
    }
    {
        float acc[8];
#pragma unroll
        for (int t = 0; t < 8; ++t) acc[t] = 0.f;
#pragma unroll
        for (int i = 0; i < 32; i += 4)
#pragma unroll
            for (int t = 0; t < 8; ++t) { const f32x4 q4 = *(const f32x4*)(qs + t * 128 + 32 * kq + i); acc[t] += (creg[i] * q4[0] + creg[i + 1] * q4[1]) + (creg[i + 2] * q4[2] + creg[i + 3] * q4[3]); }
#pragma unroll
        for (int t = 0; t < 8; ++t) cpart[(kq * 8 + t) * 128 + v] = acc[t];
    }
    __syncthreads();
    if (tid < 8) { const int t = tid; float d = 0.f;
        for (int s = 0; s < 8; ++s) d += Am[t * 8 + s];
        d += __expf(bhv[t] + m0s - mt[t]) * nq[t];
        den[t] = fmaxf(fabsf(d), __expf(-mt[t])); }
    __syncthreads();
    {
        const int t = wave; float hv[2], ss = 0.f;
#pragma unroll
        for (int j = 0; j < 2; ++j) { const int vv = lane + 64 * j; float a = 0.f;
            for (int s = 0; s < 8; ++s) a += Am[t * 8 + s] * vs[s * 128 + vv];
            const float c2 = (cpart[(0 * 8 + t) * 128 + vv] + cpart[(1 * 8 + t) * 128 + vv]) + (cpart[(2 * 8 + t) * 128 + vv] + cpart[(3 * 8 + t) * 128 + vv]);
            hv[j] = (a + __expf(bhv[t] + m0s - mt[t]) * c2) / den[t]; ss += hv[j] * hv[j]; }
        ss = wave_sum(ss);
        const float rs = rsqrtf(ss * (1.f / 128.f) + EPS);
        const float* hg = KIN(I_HNG) + layer * 768 + h * 128; bf16_t* Y = wsh(WS_YMIX);
#pragma unroll
        for (int j = 0; j < 2; ++j) { const int vv = lane + 64 * j; const size_t pr = (size_t)(m0 + t) * NPROJ;
            const float og = bf2f(cp.proj[pr + C_OC + h * 128 + vv]), z = bf2f(cp.proj[pr + C_ZC + h * 128 + vv]);
            Y[(size_t)(m0 + t) * D + 1280 + h * 128 + vv] = (bf16_t)f2bf(hv[j] * rs * hg[vv] * sigmf(og) * siluf(z)); }
    }
    {   const float wc = misc[1];
        float wv[8];
#pragma unroll
        for (int s = 0; s < 8; ++s) wv[s] = wsv[s] * vs[s * 128 + v];
        float* Co = outp + O_SC + ((size_t)((layer * 8 + b) * 6 + h)) * 16384;
#pragma unroll
        for (int i = 0; i < 32; ++i) { const int k = 32 * kq + i; float a = wc * creg[i];
#pragma unroll
            for (int s = 0; s < 8; ++s) a += ks[s * 128 + k] * wv[s];
            Co[k * 128 + v] = a; }
        if (tid < 128) { float a = wc * n0[tid]; for (int s = 0; s < 8; ++s) a += wsv[s] * ks[s * 128 + tid]; outp[O_SN + ((size_t)((layer * 8 + b) * 6 + h)) * 128 + tid] = a; }
    }
    __syncthreads();
}

template <int MODE  >
__device__ __forceinline__ void skinny_unit(Frame& F, int layer, int unit) {
    const int tid = fresh_tid(F), lane = tid & 63, wave = __builtin_amdgcn_readfirstlane(tid >> 6), hh = lane >> 5, l31 = lane & 31;
    const int n0 = unit * 64;
    const bf16_t* A = (MODE == 0 ? wsh(WS_A) : wsh(WS_YMIX)) + (size_t)MP * D;
    const bf16_t* Bt = (MODE == 0 ? wsh(WS_WIN) + (size_t)layer * NIN * D : wsh(WS_WOUT) + (size_t)layer * D * D) + (size_t)n0 * D;
    float* part = (float*)F.lds;
    f32x16 acc[2][2];
#pragma unroll
    for (int a = 0; a < 2; ++a)
#pragma unroll
        for (int b = 0; b < 2; ++b)
#pragma unroll
            for (int i = 0; i < 16; ++i) acc[a][b][i] = 0.f;
    unsigned char* stg = F.lds + wave * 16384;
    const int lr = lane >> 3, lp = lane & 7;
    const bf16_t* asrc = A + (size_t)lr * D + wave * 256 + lp * 8; const bf16_t* bsrc = Bt + (size_t)lr * D + wave * 256 + lp * 8;
    u32x4 sreg[16];
#pragma unroll
    for (int i = 0; i < 8; ++i) { sreg[i] = *(const u32x4*)(asrc + (size_t)(8 * i) * D); sreg[8 + i] = *(const u32x4*)(bsrc + (size_t)(8 * i) * D); }
    __syncthreads();
#pragma unroll 1
    for (int kb = 0; kb < 4; ++kb) {
#pragma unroll
        for (int i = 0; i < 16; ++i) { const int r = 8 * i + lr; *(u32x4*)(stg + r * 128 + ((lp ^ ((r >> 1) & 7)) << 4)) = sreg[i]; }
        if (kb < 3) {
#pragma unroll
            for (int i = 0; i < 8; ++i) { sreg[i] = *(const u32x4*)(asrc + (size_t)(8 * i) * D + 64 * (kb + 1)); sreg[8 + i] = *(const u32x4*)(bsrc + (size_t)(8 * i) * D + 64 * (kb + 1)); }
        }
#pragma unroll
        for (int k4 = 0; k4 < 4; ++k4) {
            bf16x8 a[2], b[2];
#pragma unroll
            for (int rt = 0; rt < 2; ++rt) { const int ra = 32 * rt + l31, rb = 64 + 32 * rt + l31;
                a[rt] = *(const bf16x8*)(stg + ra * 128 + (((2 * k4 + hh) ^ ((ra >> 1) & 7)) << 4));
                b[rt] = *(const bf16x8*)(stg + rb * 128 + (((2 * k4 + hh) ^ ((rb >> 1) & 7)) << 4)); }
#pragma unroll
            for (int rt = 0; rt < 2; ++rt)
#pragma unroll
                for (int ct = 0; ct < 2; ++ct) acc[rt][ct] = __builtin_amdgcn_mfma_f32_32x32x16_bf16(a[rt], b[ct], acc[rt][ct], 0, 0, 0);
        }
        asm volatile("s_waitcnt lgkmcnt(0)" ::: "memory");
    }
    __syncthreads();
#pragma unroll
    for (int rt = 0; rt < 2; ++rt)
#pragma unroll
        for (int ct = 0; ct < 2; ++ct)
#pragma unroll
            for (int i = 0; i < 16; ++i) part[(wave * 64 + 32 * rt + (i & 3) + 8 * (i >> 2) + 4 * hh) * 68 + 32 * ct + l31] = acc[rt][ct][i];
    __syncthreads();
    const int row = tid >> 3, c8 = (tid & 7) * 8, m = MP + row, jb = 2 + (row >> 3), col = n0 + c8;
    float v[8];
#pragma unroll
    for (int i = 0; i < 8; ++i) v[i] = 0.f;
#pragma unroll
    for (int w = 0; w < 8; ++w) { const f32x4 p0 = *(const f32x4*)(part + (w * 64 + row) * 68 + c8), p1 = *(const f32x4*)(part + (w * 64 + row) * 68 + c8 + 4);
        v[0] += p0[0]; v[1] += p0[1]; v[2] += p0[2]; v[3] += p0[3]; v[4] += p1[0]; v[5] += p1[1]; v[6] += p1[2]; v[7] += p1[3]; }
    if (MODE == 0) {
        const float rstd = rsqrtf(wsf(WS_SSQ)[(size_t)layer * MPAD + m] * (1.f / 2048.f) + EPS);
        const float* bp_ = wsf(WS_BIAS) + ((size_t)layer * 10 + jb) * NIN + col;
        { const f32x4 b0 = *(const f32x4*)bp_, b1 = *(const f32x4*)(bp_ + 4);
          v[0] = v[0] * rstd + b0[0]; v[1] = v[1] * rstd + b0[1]; v[2] = v[2] * rstd + b0[2]; v[3] = v[3] * rstd + b0[3];
          v[4] = v[4] * rstd + b1[0]; v[5] = v[5] * rstd + b1[1]; v[6] = v[6] * rstd + b1[2]; v[7] = v[7] * rstd + b1[3]; }
        float* out = KOUT;
        if (n0 < C_VA) {
            float ss = 0.f;
#pragma unroll
            for (int i = 0; i < 8; ++i) ss += v[i] * v[i];
            ss += __shfl_xor(ss, 1); ss += __shfl_xor(ss, 2); ss += __shfl_xor(ss, 4);
            const float r = rsqrtf(ss * (1.f / 64.f) + EPS) * (n0 < C_KA ? 0.125f * 1.4426950408889634f : 1.f);
            const float* gp = (n0 < C_KA ? KIN(I_QNG) : KIN(I_KNG)) + layer * 64 + c8;
#pragma unroll
            for (int i = 0; i < 8; ++i) v[i] *= r * gp[i];
        }
        float* dst = nullptr;
        if (n0 >= C_KA && n0 < C_ZA) dst = out + (n0 < C_VA ? O_SK : O_SV) + (size_t)(layer * 64 + row) * 768 + (col - (n0 < C_VA ? C_KA : C_VA));
        if (n0 >= C_QKC && n0 < C_VC && (row & 7) >= 5) dst = out + O_SCONV + (size_t)((layer * 8 + (row >> 3)) * 3 + ((row & 7) - 5)) * 1536 + (col - C_QKC);
        if (dst) { *(f32x4*)dst = (f32x4){v[0], v[1], v[2], v[3]}; *(f32x4*)(dst + 4) = (f32x4){v[4], v[5], v[6], v[7]}; }
        if (n0 < NPROJ) { u32x4 w; w.x = pk2(v[0], v[1]); w.y = pk2(v[2], v[3]); w.z = pk2(v[4], v[5]); w.w = pk2(v[6], v[7]); *(u32x4*)(wsh(WS_PROJ) + (size_t)m * NPROJ + col) = w; }
        else if (c8 < 16) { const float* ibias = KIN(I_IB) + layer * 6; const float* fbias = KIN(I_FB) + layer * 6; float* gates = wsf(WS_GATES);
#pragma unroll
            for (int i = 0; i < 8; ++i) { const int gi = c8 + i; if (gi < 12) { float val = v[i]; if (gi < 6) val += ibias[gi]; else val = logsigf(val + fbias[gi - 6]); gates[(size_t)m * 16 + gi] = val; } } }
    } else {
        const float* xin = layer == 0 ? KIN(I_XS) + (size_t)row * D : KOUT + (size_t)m * D;
        const float* gp = wsf(WS_MOD) + ((size_t)layer * 10 + jb) * 6144 + 4096 + col;
        const f32x4 x0 = *(const f32x4*)(xin + col), x1 = *(const f32x4*)(xin + col + 4), g0 = *(const f32x4*)gp, g1 = *(const f32x4*)(gp + 4);
        const f32x4 y0 = x0 + g0 * (f32x4){v[0], v[1], v[2], v[3]}, y1 = x1 + g1 * (f32x4){v[4], v[5], v[6], v[7]};
        float* op = KOUT + (size_t)m * D + col; *(f32x4*)op = y0; *(f32x4*)(op + 4) = y1;
        if (layer + 1 < DEPTH) {
            const float* ge = wsf(WS_GEFF) + ((size_t)(layer + 1) * 10 + jb) * D + col;
            const f32x4 a0 = y0 * *(const f32x4*)ge, a1 = y1 * *(const f32x4*)(ge + 4);
            u32x4 w; w.x = pk2(a0[0], a0[1]); w.y = pk2(a0[2], a0[3]); w.z = pk2(a1[0], a1[1]); w.w = pk2(a1[2], a1[3]);
            *(u32x4*)(wsh(WS_A) + (size_t)m * D + col) = w;
            float ss = (y0[0] * y0[0] + y0[1] * y0[1]) + (y0[2] * y0[2] + y0[3] * y0[3]) + (y1[0] * y1[0] + y1[1] * y1[1]) + (y1[2] * y1[2] + y1[3] * y1[3]);
            ss += __shfl_xor(ss, 1); ss += __shfl_xor(ss, 2); ss += __shfl_xor(ss, 4);
            if ((tid & 7) == 0) atomicAdd(wsf(WS_SSQ) + (size_t)(layer + 1) * MPAD + m, ss);
        }
    }
}

constexpr int CW_CNT = 16384;
__device__ __forceinline__ void unit_publish(unsigned* cnt) {
    asm volatile("s_waitcnt vmcnt(0)" ::: "memory");
    __syncthreads();
    if (threadIdx.x == 0) {
        __builtin_amdgcn_fence(__ATOMIC_RELEASE, "agent");
        asm volatile("s_waitcnt vmcnt(0)" ::: "memory");
        __hip_atomic_fetch_add(cnt, 1u, __ATOMIC_RELAXED, __HIP_MEMORY_SCOPE_AGENT);
    }
}
__device__ __forceinline__ void unit_wait(unsigned* cnt, unsigned need) {
    if (threadIdx.x == 0) {
        unsigned sp = 0u;
        while (__hip_atomic_load(cnt, __ATOMIC_RELAXED, __HIP_MEMORY_SCOPE_AGENT) < need) { __builtin_amdgcn_s_sleep(2); if (++sp > (1u << 24)) break; }
        __builtin_amdgcn_fence(__ATOMIC_ACQUIRE, "agent");
        asm volatile("s_waitcnt vmcnt(0)" ::: "memory");
    }
    __syncthreads();
}
__device__ __forceinline__ void phase_ma(Frame& F, int layer, int kinds, bool dynamic) {
    constexpr int U_SKO = 32, U_M1 = 384, U_SGU = 256, U_AT = ATT_JOBS, U_SK = 133, U_TOT = U_SKO + U_M1 + U_SGU + U_AT + U_SK;
    unsigned* ctr = (unsigned*)(KA()->ws + WS_CTL) + CW_Q + 64 * layer;
    unsigned* cnt_sko = (unsigned*)(KA()->ws + WS_CTL) + CW_CNT + 64 * layer;
    volatile unsigned* slot = (volatile unsigned*)(F.lds + LDSCTL_OFF + 64);
    unsigned pre = 0u;
    if (dynamic) { if (F.tid == 0) pre = __hip_atomic_fetch_add(ctr, 1u, __ATOMIC_RELAXED, __HIP_MEMORY_SCOPE_AGENT); }
    else pre = (unsigned)F.bx;
    for (;;) {
        unsigned u;
        if (dynamic) {
            __syncthreads();
            if (F.tid == 0) slot[0] = pre;
            __syncthreads();
            u = slot[0];
            if (u >= (unsigned)U_TOT) break;
            if (F.tid == 0) pre = __hip_atomic_fetch_add(ctr, 1u, __ATOMIC_RELAXED, __HIP_MEMORY_SCOPE_AGENT);
        } else { u = pre; if (u >= (unsigned)U_TOT) break; pre += (unsigned)F.G; }
        int r = (int)u;
        if (r < U_SKO) { if (dynamic && layer > 0) { skinny_unit<1>(F, layer - 1, r); unit_publish(cnt_sko); } continue; } r -= U_SKO;
        if (r < U_M1) { if (kinds & 2) m1_unit(F, layer, r); continue; } r -= U_M1;
        if (r < U_SK) { if (kinds & 8) { if (dynamic && layer > 0) unit_wait(cnt_sko, (unsigned)U_SKO); skinny_unit<0>(F, layer, r); } continue; } r -= U_SK;
        if (r < U_SGU) { const int g = r & 3, ch = (r >> 2) & 31, b = r >> 7; if (kinds & 4) sgu_unit_mfma(F, layer, b * SEQ + ch * 128, g); continue; } r -= U_SGU;
        if (kinds & 1) attn_job(F, layer, r);
    }
    __syncthreads();
}
__device__ __forceinline__ void phase_mixs(Frame& F, int layer) {
    constexpr int U_SA = 96, U_MS = 48, U_SGUS = 32, U_TOT = U_SA + U_MS + U_SGUS;
    for (int u = F.G - 1 - F.bx; u < U_TOT; u += F.G) {
        int r = u;
        if (r < U_SA) { __syncthreads(); sattn_item(F, layer, r * 8 + F.wave); __syncthreads(); continue; } r -= U_SA;
        if (r < U_MS) { ms_unit(F, layer, r); continue; } r -= U_MS;
        { const int g = r & 3, b = r >> 2; sgu_unit(F, layer, MP + b * 8, 8, g, KOUT + O_SGU + (size_t)(layer * 64 + b * 8) * 512); }
    }
}

__device__ __forceinline__ void phase_m3(Frame& F, int layer, bool dynamic, int kinds) {
    constexpr int U_MIXS = 176, U_M3 = 384, U_CB = 256, U_TOT = U_MIXS + U_M3 + U_CB;
    unsigned* ctr = (unsigned*)(KA()->ws + WS_CTL) + CW_Q + 64 * (DEPTH + layer);
    volatile unsigned* slot = (volatile unsigned*)(F.lds + LDSCTL_OFF + 64);
    unsigned pre = 0u;
    if (dynamic) { if (F.tid == 0) pre = __hip_atomic_fetch_add(ctr, 1u, __ATOMIC_RELAXED, __HIP_MEMORY_SCOPE_AGENT); }
    else pre = (unsigned)F.bx;
    for (;;) {
        unsigned u;
        if (dynamic) {
            __syncthreads();
            if (F.tid == 0) slot[0] = pre;
            __syncthreads();
            u = slot[0];
            if (u >= (unsigned)U_TOT) break;
            if (F.tid == 0) pre = __hip_atomic_fetch_add(ctr, 1u, __ATOMIC_RELAXED, __HIP_MEMORY_SCOPE_AGENT);
        } else { u = pre; if (u >= (unsigned)U_TOT) break; pre += (unsigned)F.G; }
        int r = (int)u;
        if (r < U_MIXS) {
            if (!(kinds & 1)) continue;
            if (r < 96) { if (kinds & 8) { __syncthreads(); sattn_item(F, layer, r * 8 + F.wave); } }
            else if (r < 144) { if (kinds & 16) ms_unit(F, layer, r - 96); }
            else if (kinds & 32) { const int q_ = r - 144, g = q_ & 3, b = q_ >> 2; sgu_unit(F, layer, MP + b * 8, 8, g, KOUT + O_SGU + (size_t)(layer * 64 + b * 8) * 512); }
            continue; } r -= U_MIXS;
        if (r < U_M3) { if (kinds & 2) m3_unit(F, layer, r); continue; } r -= U_M3;
        if (!(kinds & 4)) continue;
#pragma unroll
        for (int i = 0; i < 4; ++i) attn_combine_row(F, r * 32 + F.wave * 4 + i);
    }
    __syncthreads();
}

constexpr int N_PHASES = 2 + 5 * DEPTH;
__global__ void __launch_bounds__(512, 2) fwd_kernel(Args args) {
    extern __shared__ __attribute__((aligned(16))) unsigned char lds[];
    LAS unsigned char* ldsl = (LAS unsigned char*)lds;
    for (int u = threadIdx.x; u < (LDS_BYTES - LDSCTL_OFF) / 4; u += 512) ((LAS unsigned*)(ldsl + LDSCTL_OFF))[u] = 0u;
    __syncthreads();
    unsigned* ctl = (unsigned*)(KA()->ws + WS_CTL);
    XcdBarrier bar; bar.bar = ctl + CW_BAR; bar.x = 0; bar.st = nullptr;
    const int lo = args.ph_lo, hi = args.ph_hi;
    if (hi - lo > 1) bar = xcd_barrier_post(ctl + CW_BAR, (volatile LAS unsigned*)(ldsl + LDSCTL_OFF + 32));

#ifndef DUP_MASK
#define DUP_MASK 0
#endif
    for (int ph2 = 2 * lo; ph2 < 2 * hi; ++ph2) {
        const int ph = ph2 >> 1;
        if (ph2 & 1) {
            const int kk_ = ph < 2 ? ph : 2 + (ph - 2) % 5;
            if (!((DUP_MASK >> kk_) & 1)) { if (DUP_MASK & 128) xcd_barrier(bar); continue; }
        }
        Frame F; F.lds = lds;
        { int t_ = threadIdx.x; asm volatile("" : "+v"(t_)); F.tid = t_; F.lane = t_ & 63; F.wave = __builtin_amdgcn_readfirstlane(t_ >> 6); }
        int bx_ = blockIdx.x; asm volatile("" : "+s"(bx_));
        F.G = gridDim.x; F.vcu = (F.G % 8 == 0) ? (bx_ % 8) * (F.G / 8) + bx_ / 8 : bx_; F.bx = bx_;
#ifndef DBG_MASK
#define DBG_MASK 0xff
#endif
        if (ph == 0) { if (DBG_MASK & 1) phase_p0(F); }
        else if (ph == 1) { if (DBG_MASK & 2) phase_p1(F, !(ph2 & 1)); }
        else {
            const int l = (ph - 2) / 5, k = (ph - 2) % 5;
            if (k == 0) { if (DBG_MASK & 4) {
                pg8::Gemm g{wsh(WS_A), wsh(WS_WIN) + (size_t)l * NIN * D, MP, NPROJ, D}; pg8::OrderIn S; S.init(MP, NPROJ, F.G, F.bx); S.i0 = 0; S.i1 = (F.G == 256) ? 4 : (1 << 20);
#ifndef PROBE_NOSTORE
#define PROBE_NOSTORE 0
#endif
                pg8::EpiIn E{l, (PROBE_NOSTORE && (ph2 & 1)) ? 1 : 0};
                if ((F.G == 256) && !(ph2 & 1) && l < DEPTH - 1 && (F.bx & 1)) { bias_unit(F, l + 1, F.bx >> 1); __syncthreads(); }
                pg8::gemm_phase<pg8::EpiIn, pg8::OrderIn>(ldsl, g, S, E, F.tid);
                if (!(ph2 & 1)) { if (F.G == 256) { if (!(F.bx & 1)) gate_unit(F, l, F.bx >> 1); } else for (int u = F.bx; u < 128; u += F.G) gate_unit(F, l, u); } }
            } else if (k == 1) {
#ifndef DUP_SUB
#define DUP_SUB 31
#endif
                if (DBG_MASK & 8) {
                    if (!(ph2 & 1) && F.G == 256) {
                        pg8::Gemm g{wsh(WS_A), wsh(WS_WIN) + (size_t)l * NIN * D, MP, NPROJ, D}; pg8::OrderIn S; S.init(MP, NPROJ, F.G, F.bx); S.i0 = 4; S.i1 = 5;
                        pg8::EpiIn E{l, 0};
                        pg8::gemm_phase<pg8::EpiIn, pg8::OrderIn>(ldsl, g, S, E, F.tid);
                    }
                    phase_ma(F, l, (ph2 & 1) ? DUP_SUB : 31, !(ph2 & 1));
                }
            } else if (k == 2) {
                if (DBG_MASK & 16) phase_m2(F, l);
            } else if (k == 3) {
                if (DBG_MASK & 32) phase_m3(F, l, !(ph2 & 1), (ph2 & 1) ? DUP_SUB : 63);
            } else if (DBG_MASK & 64) {
                pg8::Gemm g{wsh(WS_YMIX), wsh(WS_WOUT) + (size_t)l * D * D, MP, D, D}; pg8::StaticOrder S; S.init(MP, D, F.G, F.bx);
                pg8::EpiOut E{l, (ph2 & 1) ? 0 : ((DUP_MASK >> 6) & 1)};
                pg8::gemm_phase<pg8::EpiOut, pg8::StaticOrder>(ldsl, g, S, E, F.tid);
                if (l == DEPTH - 1 && !E.nostore) { for (int u = F.bx; u < 32; u += F.G) skinny_unit<1>(F, l, u); }
            }
        }
        if (ph2 + 1 < 2 * hi) xcd_barrier(bar);
    }
}

extern "C" void kernel_launch(void* const* d_in, const int* in_sizes, int n_in, void* d_out, int out_size, void* d_ws, size_t ws_size, hipStream_t stream) {
    static int grid = 0;
    if (grid == 0) {
        if (n_in != 26 || (size_t)out_size != O_END || ws_size < WS_END) { fprintf(stderr, "kernel_launch: unexpected shapes: n_in %d out %d ws %zu\n", n_in, out_size, ws_size); grid = -1; return; }
        int dev = 0, cus = 0, per_cu = 0;
        if (hipGetDevice(&dev) != hipSuccess || hipDeviceGetAttribute(&cus, hipDeviceAttributeMultiprocessorCount, dev) != hipSuccess) { grid = -1; return; }
        if (hipFuncSetAttribute((const void*)fwd_kernel, hipFuncAttributeMaxDynamicSharedMemorySize, LDS_BYTES) != hipSuccess) { fprintf(stderr, "kernel_launch: hipFuncSetAttribute failed\n"); grid = -1; return; }
        if (hipOccupancyMaxActiveBlocksPerMultiprocessor(&per_cu, (const void*)fwd_kernel, 512, LDS_BYTES) != hipSuccess || per_cu < 1) { fprintf(stderr, "kernel_launch: occupancy query says %d blocks/CU\n", per_cu); }
        (void)hipGetLastError();
        grid = cus;
    }
    if (grid < 0) return;
    if (hipMemsetAsync((char*)d_ws + WS_CTL, 0, CTL_ZERO_BYTES, stream) != hipSuccess) return;
    Args a{};
    for (int i = 0; i < 26; ++i) a.in[i] = (const float*)d_in[i];
    a.out = (float*)d_out; a.ws = (unsigned char*)d_ws;
#if MK_N_LAUNCHES == 1
    a.ph_lo = 0; a.ph_hi = N_PHASES;
    hipLaunchKernelGGL(fwd_kernel, dim3(grid), dim3(512), LDS_BYTES, stream, a);
#else
    for (int p = 0; p < N_PHASES; ++p) { a.ph_lo = p; a.ph_hi = p + 1; hipLaunchKernelGGL(fwd_kernel, dim3(grid), dim3(512), LDS_BYTES, stream, a); }
#endif
}
```
